# Optimizing an MI355X kernel written in HIP

```python
import math
import jax, jax.numpy as jnp
from jax import lax
import numpy as np

D_MODEL = 1024
BATCH = 8
SEQ = 2048
DEPTH = 4
DEC_BATCH = 128
DEC_SEQ = 1
PAST_LEN = 16384
PAGE_SIZE = 128

N_MIXERS = 2
N_A = (DEPTH + 1) // 2
N_B = DEPTH // 2
A_HEADS = 8
A_DK = 128
A_DV = 128
A_QK_DIM = A_HEADS * A_DK
A_V_DIM = A_HEADS * A_DV
A_CONV_DIM = 2 * A_QK_DIM + A_V_DIM
A_IN_DIM = A_CONV_DIM + A_V_DIM + 2 * A_HEADS
CONV_W = 4
CHUNK_A = 64
B_WIDTH = 2 * D_MODEL
B_GROUPS = 8
B_GROUP_DIM = B_WIDTH // B_GROUPS
CHUNK_B = 128
D_FF = 2816
FFN_RES = 0.5
N_SUB = 3
EPS = 1e-6

kernel_name = "hybrid_gdn_gmlp_macaron_adaln_step"


def rms_norm(x, w):
    xf = x.astype(jnp.float32)
    y = xf * lax.rsqrt(jnp.mean(xf * xf, axis=-1, keepdims=True) + EPS)
    return (y * w.astype(jnp.float32)).astype(x.dtype)


def layer_norm(x, w, b):
    xf = x.astype(jnp.float32)
    mu = jnp.mean(xf, axis=-1, keepdims=True)
    xc = xf - mu
    y = xc * lax.rsqrt(jnp.mean(xc * xc, axis=-1, keepdims=True) + EPS)
    return (y * w.astype(jnp.float32) + b.astype(jnp.float32)).astype(x.dtype)


def l2_norm(x):
    xf = x.astype(jnp.float32)
    return xf * lax.rsqrt(jnp.sum(xf * xf, axis=-1, keepdims=True) + EPS)


def swiglu(h, w_gu, w_down):
    gu = h @ w_gu
    return (jax.nn.silu(gu[..., :D_FF]) * gu[..., D_FF:]) @ w_down


def gated_delta_rule(q, k, v, g, beta, S0):
    f32 = jnp.float32
    Bn, L, H, _ = q.shape
    C = min(CHUNK_A, L)
    n = -(-L // C)
    pad = n * C - L

    def blocks(t):
        t = jnp.pad(t.astype(f32), [(0, 0), (0, pad)] + [(0, 0)] * (t.ndim - 2))
        t = t.reshape((Bn, n, C) + t.shape[2:])
        return jnp.moveaxis(t, 3, 1)

    q = blocks(q) * (A_DK ** -0.5)
    k, v, g, beta = blocks(k), blocks(v), blocks(g), blocks(beta)
    decay = jnp.cumsum(g, axis=-1)
    idx = jnp.arange(C)
    causal = idx[:, None] >= idx[None, :]
    strict = idx[:, None] > idx[None, :]
    gamma = jnp.exp(jnp.where(causal, decay[..., :, None] - decay[..., None, :], -jnp.inf))
    k_beta = k * beta[..., None]
    m = jnp.where(strict, jnp.einsum('bhnck,bhnsk->bhncs', k_beta, k) * gamma, 0.0)
    eye = jnp.eye(C, dtype=f32)
    rhs = jnp.concatenate([v * beta[..., None], k_beta * jnp.exp(decay)[..., None]], axis=-1)
    sol = lax.linalg.triangular_solve(eye + m, rhs, left_side=True, lower=True, unit_diagonal=True)
    u_val, w_key = sol[..., :A_DV], sol[..., A_DV:]
    attn = jnp.where(causal, jnp.einsum('bhnck,bhnsk->bhncs', q, k) * gamma, 0.0)

    def step(S, xs):
        q_c, k_c, u_c, w_c, attn_c, d_c = xs
        v_new = u_c - jnp.einsum('bhck,bhkv->bhcv', w_c, S)
        o_c = (jnp.einsum('bhck,bhkv->bhcv', q_c * jnp.exp(d_c)[..., None], S)
               + jnp.einsum('bhcs,bhsv->bhcv', attn_c, v_new))
        d_last = d_c[..., -1]
        S = (S * jnp.exp(d_last)[..., None, None]
             + jnp.einsum('bhck,bhcv->bhkv', k_c * jnp.exp(d_last[..., None] - d_c)[..., None], v_new))
        return S, o_c

    xs = tuple(jnp.moveaxis(t, 2, 0) for t in (q, k, u_val, w_key, attn, decay))
    S, o = lax.scan(step, S0.astype(f32), xs)
    o = jnp.moveaxis(jnp.moveaxis(o, 0, 2), 1, 3)
    o = o.reshape(Bn, n * C, H, A_DV)[:, :L]
    return o, S


def mixer_a(h, conv_buf, S0, w_in, w_conv, a_log, dt_bias, w_onorm, w_out):
    Bn, L, _ = h.shape
    proj = h @ w_in
    qkv_pre = proj[..., :A_CONV_DIM]
    z = proj[..., A_CONV_DIM:A_CONV_DIM + A_V_DIM]
    b_logit = proj[..., A_CONV_DIM + A_V_DIM:A_CONV_DIM + A_V_DIM + A_HEADS]
    a_logit = proj[..., A_CONV_DIM + A_V_DIM + A_HEADS:]
    full = jnp.concatenate([conv_buf.astype(qkv_pre.dtype), qkv_pre], axis=1)
    conv = full[:, 0:L] * w_conv[0]
    for j in range(1, CONV_W):
        conv = conv + full[:, j:j + L] * w_conv[j]
    qkv = jax.nn.silu(conv)
    new_buf = full[:, L:]
    q = l2_norm(qkv[..., :A_QK_DIM].reshape(Bn, L, A_HEADS, A_DK))
    k = l2_norm(qkv[..., A_QK_DIM:2 * A_QK_DIM].reshape(Bn, L, A_HEADS, A_DK))
    v = qkv[..., 2 * A_QK_DIM:].reshape(Bn, L, A_HEADS, A_DV)
    beta = jax.nn.sigmoid(b_logit.astype(jnp.float32))
    g = -jnp.exp(a_log.astype(jnp.float32)) * jax.nn.softplus(a_logit.astype(jnp.float32) + dt_bias.astype(jnp.float32))
    o, S = gated_delta_rule(q, k, v, g, beta, S0)
    o = rms_norm(o.astype(h.dtype), w_onorm) * jax.nn.silu(z.reshape(Bn, L, A_HEADS, A_DV))
    y = o.reshape(Bn, L, A_V_DIM) @ w_out
    return y, new_buf, S.astype(S0.dtype)


def mixer_b(h, w_in, vnorm_w, vnorm_b, w_s, b_s, w_out):
    Bn, L, _ = h.shape
    zz = jax.nn.gelu(h @ w_in)
    u, v = zz[..., :B_WIDTH], zz[..., B_WIDTH:]
    v = layer_norm(v, vnorm_w, vnorm_b)
    n = -(-L // CHUNK_B)
    pad = n * CHUNK_B - L
    vb = jnp.pad(v, ((0, 0), (0, pad), (0, 0))).reshape(Bn, n, CHUNK_B, B_GROUPS, B_GROUP_DIM)
    causal = jnp.tril(jnp.ones((CHUNK_B, CHUNK_B), dtype=bool))
    ws = jnp.where(causal, w_s, 0.0)
    mixed = jnp.einsum('gts,bnsgd->bntgd', ws, vb) + b_s.T[:, :, None]
    mixed = mixed.reshape(Bn, n * CHUNK_B, B_WIDTH)[:, :L]
    y = (u * mixed) @ w_out
    return y, v


def trunk(x, c, conv_bufs, states, w_ada, b_ada, norm_w, ffn_w_gu, ffn_w_down,
          a_w_in, a_w_conv, a_log, a_dt_bias, a_w_onorm, a_w_out,
          b_w_in, b_vnorm_w, b_vnorm_b, b_w_s, b_b_s, b_w_out, final_norm_w):
    Bn = x.shape[0]
    new_conv, new_S, v_rows = [], [], []
    for i in range(DEPTH):
        mod = (jax.nn.silu(c) @ w_ada[i] + b_ada[i]).reshape(Bn, N_SUB, 3, D_MODEL)
        shift, scale, gate = mod[:, :, 0], mod[:, :, 1], mod[:, :, 2]
        h = rms_norm(x, norm_w[i, 0]) * (1.0 + scale[:, 0, None]) + shift[:, 0, None]
        x = x + FFN_RES * (1.0 + gate[:, 0, None]) * swiglu(h, ffn_w_gu[i, 0], ffn_w_down[i, 0])
        h = rms_norm(x, norm_w[i, 1]) * (1.0 + scale[:, 1, None]) + shift[:, 1, None]
        li = i // N_MIXERS
        if i % N_MIXERS == 0:
            y, buf, S = mixer_a(h, conv_bufs[li], states[li], a_w_in[li], a_w_conv[li], a_log[li],
                                a_dt_bias[li], a_w_onorm[li], a_w_out[li])
            new_conv.append(buf)
            new_S.append(S)
        else:
            y, v = mixer_b(h, b_w_in[li], b_vnorm_w[li], b_vnorm_b[li], b_w_s[li], b_b_s[li], b_w_out[li])
            v_rows.append(v)
        x = x + (1.0 + gate[:, 1, None]) * y
        h = rms_norm(x, norm_w[i, 2]) * (1.0 + scale[:, 2, None]) + shift[:, 2, None]
        x = x + FFN_RES * (1.0 + gate[:, 2, None]) * swiglu(h, ffn_w_gu[i, 1], ffn_w_down[i, 1])
    y = rms_norm(x, final_norm_w)
    return y, jnp.stack(new_conv), jnp.stack(new_S), jnp.stack(v_rows)


def setup_inputs(seed: int = 0) -> dict:
    key = jax.random.key(seed)
    ks = jax.random.split(key, 26)
    f32 = jnp.float32

    def nrm(k, shape, s):
        return jax.random.normal(k, shape, f32) * s

    dt = jnp.exp(jax.random.uniform(ks[14], (N_A, A_HEADS), f32, math.log(1e-3), math.log(1e-1)))
    return {
        "x_prompt": nrm(ks[0], (BATCH, SEQ, D_MODEL), 1.0),
        "x_sample": nrm(ks[1], (DEC_BATCH, DEC_SEQ, D_MODEL), 1.0),
        "state_a_conv": nrm(ks[2], (N_A, DEC_BATCH, CONV_W - 1, A_CONV_DIM), 1.0),
        "state_a_S": nrm(ks[3], (N_A, DEC_BATCH, A_HEADS, A_DK, A_DV), 0.5),
        "c_prompt": nrm(ks[4], (BATCH, D_MODEL), 1.0),
        "c_sample": nrm(ks[5], (DEC_BATCH, D_MODEL), 1.0),
        "w_ada": nrm(ks[6], (DEPTH, D_MODEL, N_SUB * 3 * D_MODEL), 0.1 * D_MODEL ** -0.5),
        "b_ada": nrm(ks[7], (DEPTH, N_SUB * 3 * D_MODEL), 0.01),
        "norm_w": 1.0 + nrm(ks[8], (DEPTH, N_SUB, D_MODEL), 0.02),
        "ffn_w_gu": nrm(ks[9], (DEPTH, 2, D_MODEL, 2 * D_FF), D_MODEL ** -0.5),
        "ffn_w_down": nrm(ks[10], (DEPTH, 2, D_FF, D_MODEL), D_FF ** -0.5),
        "a_w_in": nrm(ks[11], (N_A, D_MODEL, A_IN_DIM), D_MODEL ** -0.5),
        "a_w_conv": nrm(ks[12], (N_A, CONV_W, A_CONV_DIM), CONV_W ** -0.5),
        "a_log": jnp.log(jax.random.uniform(ks[13], (N_A, A_HEADS), f32, 1.0, 16.0)),
        "a_dt_bias": dt + jnp.log(-jnp.expm1(-dt)),
        "a_w_onorm": 1.0 + nrm(ks[15], (N_A, A_DV), 0.02),
        "a_w_out": nrm(ks[16], (N_A, A_V_DIM, D_MODEL), A_V_DIM ** -0.5),
        "b_w_in": nrm(ks[17], (N_B, D_MODEL, 2 * B_WIDTH), D_MODEL ** -0.5),
        "b_vnorm_w": 1.0 + nrm(ks[18], (N_B, B_WIDTH), 0.02),
        "b_vnorm_b": nrm(ks[19], (N_B, B_WIDTH), 0.01),
        "b_w_s": nrm(ks[20], (N_B, B_GROUPS, CHUNK_B, CHUNK_B), CHUNK_B ** -0.5),
        "b_b_s": 1.0 + nrm(ks[21], (N_B, B_GROUPS, CHUNK_B), 0.02),
        "b_w_out": nrm(ks[22], (N_B, B_WIDTH, D_MODEL), B_WIDTH ** -0.5),
        "final_norm_w": 1.0 + nrm(ks[23], (D_MODEL,), 0.02),
    }


def reference(x_prompt, x_sample, state_a_conv, state_a_S, c_prompt, c_sample,
              w_ada, b_ada, norm_w, ffn_w_gu, ffn_w_down,
              a_w_in, a_w_conv, a_log, a_dt_bias, a_w_onorm, a_w_out,
              b_w_in, b_vnorm_w, b_vnorm_b, b_w_s, b_b_s, b_w_out, final_norm_w):
    zero_conv = jnp.zeros((N_A, x_prompt.shape[0], CONV_W - 1, A_CONV_DIM), x_prompt.dtype)
    zero_S = jnp.zeros((N_A, x_prompt.shape[0], A_HEADS, A_DK, A_DV), state_a_S.dtype)
    y_prompt, conv_prompt, S_prompt, _ = trunk(
        x_prompt, c_prompt, zero_conv, zero_S, w_ada, b_ada, norm_w, ffn_w_gu, ffn_w_down,
        a_w_in, a_w_conv, a_log, a_dt_bias, a_w_onorm, a_w_out,
        b_w_in, b_vnorm_w, b_vnorm_b, b_w_s, b_b_s, b_w_out, final_norm_w)
    y_sample, conv_sample, S_sample, v_sample = trunk(
        x_sample, c_sample, state_a_conv, state_a_S, w_ada, b_ada, norm_w, ffn_w_gu, ffn_w_down,
        a_w_in, a_w_conv, a_log, a_dt_bias, a_w_onorm, a_w_out,
        b_w_in, b_vnorm_w, b_vnorm_b, b_w_s, b_b_s, b_w_out, final_norm_w)
    return (y_prompt, y_sample, conv_prompt, S_prompt, conv_sample, S_sample, v_sample)
```

```cpp
#include <hip/hip_runtime.h>
#include <hip/hip_cooperative_groups.h>
#include <cstdio>
namespace cg = cooperative_groups;
#ifndef MK_MULTI
#define MK_MULTI 1
#endif
namespace pg8 {
#define PG8_LAS __attribute__((address_space(3)))
typedef unsigned short bf16_t;
typedef short bf16x8 __attribute__((ext_vector_type(8)));
typedef float f32x4 __attribute__((ext_vector_type(4)));
typedef unsigned u32x4 __attribute__((ext_vector_type(4)));
constexpr int BM = 256, BK = 64, HALF = 128, HTB = HALF * BK * 2  , STAGE_BYTES = 8 * HTB, NXCD = 8, WGM = 8;

__host__ __device__ __forceinline__ int lds_byte(int r, int c) { const int st = (r >> 4) * 2 + (c >> 5), rr = r & 15, cc = c & 31, ob = rr * 64 + cc * 2; return st * 1024 + (ob ^ (((ob >> 9) & 1) << 5)); }
__host__ __device__ __forceinline__ void stage_rc(int b, int& R, int& C) { const int st = b / 1024, sb = b % 1024, swz = sb ^ (((sb >> 9) & 1) << 5); R = (st >> 1) * 16 + swz / 64; C = (st & 1) * 32 + (swz % 64) / 2; }
__host__ __device__ __forceinline__ int perm32(int rho) { const int n = rho >> 4, i = rho & 15; return 8 * (i >> 2) + 4 * n + (i & 3); }

struct Unit { int pm, pn; };
struct Gemm { const bf16_t* A; const bf16_t* Bt; int M, N, K; };

struct StaticOrder {
    int nM, nN, nwg, G, c;
    __host__ __device__ void init(int M, int N, int G_, int c_) { nM = M / BM; nN = N / BM; nwg = nM * nN; G = G_; c = c_; }
    __host__ __device__ bool next(int i, Unit& u) const {
        const long L = (long)i * G + c; if (L >= nwg) return false;
        int wgid = (int)L; { const int q = nwg / NXCD, r = nwg % NXCD, xcd = wgid % NXCD, off = wgid / NXCD; wgid = (xcd < r ? xcd * (q + 1) : r * (q + 1) + (xcd - r) * q) + off; }
        const int nig = WGM * nN, gid = wgid / nig, fm = gid * WGM, gsz = (nM - fm) < WGM ? (nM - fm) : WGM;
        u.pm = fm + ((wgid % nig) % gsz); u.pn = (wgid % nig) / gsz; return true;
    }
    __device__ __forceinline__ void a_ready(const Unit&) const {}
    __device__ __forceinline__ void done(const Unit&) const {}
};
__device__ __forceinline__ unsigned cvt_pk_bf16(float lo, float hi) { unsigned r; asm volatile("v_cvt_pk_bf16_f32 %0, %1, %2" : "=v"(r) : "v"(lo), "v"(hi)); return r; }
typedef float f32x2 __attribute__((ext_vector_type(2)));
template <class Epi, class Sched, bool STAMP = false>
__device__ __forceinline__ void gemm_phase(PG8_LAS unsigned char* lds, const Gemm g, const Sched& S, const Epi& E, unsigned long long* stamps) {
    const int tid = threadIdx.x, wid = __builtin_amdgcn_readfirstlane(tid >> 6), lane = tid & 63, wr = wid >> 2, wc = wid & 3, fr = lane & 15, fq = lane >> 4;
    const int K = g.K, nt = K / BK;
    int ts_lo = 0, ts_hi = 0, nts = 0; const unsigned long long rt_entry = STAMP ? (unsigned long long)wall_clock64() : 0ull;
#define PG8_STAMP() do { if (STAMP && wid == 0 && nts < 64) { const unsigned long long _c = (unsigned long long)clock64(); \
        ts_lo = (lane == nts) ? (int)(unsigned)_c : ts_lo; ts_hi = (lane == nts) ? (int)(unsigned)(_c >> 32) : ts_hi; ++nts; } } while (0)
    PG8_STAMP();
    unsigned voffA[2], voffB[2];
#pragma unroll
    for (int i = 0; i < 2; ++i) { int R, C; stage_rc(tid * 16 + i * 8192, R, C); const int Rb = Epi::PERM ? ((R & ~31) + perm32(R & 31)) : R;
        voffA[i] = (unsigned)(R * K + C) * 2u; voffB[i] = (unsigned)(Rb * K + C) * 2u; }
    const size_t kstep = (size_t)(BK * 2);
    const size_t hstep = (size_t)HALF * K * 2;
    const size_t tstep = 2 * hstep;
    const unsigned ldsw = (unsigned)wid * 1024u;
    const int aoff = lds_byte(wr * 64 + fr, fq * 8), boff = lds_byte(wc * 32 + fr, fq * 8);
#define PG8_SA(b, h) (((b) * 2 + (h)) * HTB)
#define PG8_SB(b, h) ((4 + (b) * 2 + (h)) * HTB)
#define PG8_STAGE(bufoff, gbase, voff) do { _Pragma("unroll") for (int _i = 0; _i < 2; ++_i) \
        __builtin_amdgcn_global_load_lds((const unsigned*)((const char*)(gbase) + (voff)[_i]), (PG8_LAS unsigned*)(lds + (bufoff) + ldsw + _i * 8192), 16, 0, 0); } while (0)
#define PG8_LDA(dst, b, h) do { _Pragma("unroll") for (int m = 0; m < 4; ++m) _Pragma("unroll") for (int k = 0; k < 2; ++k) dst[m][k] = *(const PG8_LAS bf16x8*)(lds + PG8_SA(b, h) + aoff + m * 2048 + k * 1024); } while (0)
#define PG8_LDB(dst, b, h) do { _Pragma("unroll") for (int n = 0; n < 2; ++n) _Pragma("unroll") for (int k = 0; k < 2; ++k) dst[n][k] = *(const PG8_LAS bf16x8*)(lds + PG8_SB(b, h) + boff + n * 2048 + k * 1024); } while (0)
#define PG8_MMA(ai, bj, At, Bt) do { __builtin_amdgcn_s_setprio(1); _Pragma("unroll") for (int m = 0; m < 4; ++m) _Pragma("unroll") for (int n = 0; n < 2; ++n) _Pragma("unroll") for (int k = 0; k < 2; ++k) \
        acc[ai][bj][m][n] = __builtin_amdgcn_mfma_f32_16x16x32_bf16(Bt[n][k], At[m][k], acc[ai][bj][m][n], 0, 0, 0); __builtin_amdgcn_s_setprio(0); } while (0)
#define PG8_WAIT_V(n) asm volatile("s_waitcnt vmcnt(" #n ")" ::: "memory")
#define PG8_WAIT_L(n) asm volatile("s_waitcnt lgkmcnt(" #n ")" ::: "memory")
#define PG8_BAR __builtin_amdgcn_s_barrier()
#define PG8_SCHED __builtin_amdgcn_sched_barrier(0)
    Unit cur, nxt; int ui = 0;
    if (!S.next(0, cur)) return;
    f32x4 acc[2][2][4][2];
#pragma unroll
    for (int a = 0; a < 2; ++a)
#pragma unroll
        for (int b = 0; b < 2; ++b)
#pragma unroll
            for (int m = 0; m < 4; ++m)
#pragma unroll
                for (int n = 0; n < 2; ++n) acc[a][b][m][n] = (f32x4){0.f, 0.f, 0.f, 0.f};
    bf16x8 At[4][2], B0[2][2], B1[2][2];
    const char* cA = (const char*)g.A + (size_t)cur.pm * tstep; const char* cB = (const char*)g.Bt + (size_t)cur.pn * tstep;
    S.a_ready(cur);
    PG8_STAGE(PG8_SB(0, 0), cB, voffB); PG8_STAGE(PG8_SA(0, 0), cA, voffA); PG8_STAGE(PG8_SB(0, 1), cB + hstep, voffB); PG8_STAGE(PG8_SA(0, 1), cA + hstep, voffA);
    if (wr == 1) PG8_BAR;
    PG8_WAIT_V(4); PG8_BAR;
    PG8_STAGE(PG8_SB(1, 0), cB + kstep, voffB); PG8_STAGE(PG8_SA(1, 0), cA + kstep, voffA); PG8_STAGE(PG8_SB(1, 1), cB + hstep + kstep, voffB);
    PG8_WAIT_V(6); PG8_BAR;
    PG8_STAMP();
    for (;;) {
        const bool has_next = S.next(ui + 1, nxt);
        const char* nA = has_next ? (const char*)g.A + (size_t)nxt.pm * tstep : cA; const char* nB = has_next ? (const char*)g.Bt + (size_t)nxt.pn * tstep : cB;
        for (int t = 0; t < nt; t += 2) {
            const bool last = (t == nt - 2);
            const char* a1 = cA + (size_t)(t + 1) * kstep;
            const char* a2 = last ? nA : cA + (size_t)(t + 2) * kstep; const char* b2 = last ? nB : cB + (size_t)(t + 2) * kstep;
            const char* a3 = a2 + kstep; const char* b3 = b2 + kstep;
            if (last && has_next) S.a_ready(nxt);
            PG8_LDB(B0, 0, 0); PG8_SCHED; PG8_LDA(At, 0, 0); PG8_STAGE(PG8_SA(1, 1), a1 + hstep, voffA);
            PG8_WAIT_L(8); PG8_BAR; PG8_WAIT_L(0); PG8_MMA(0, 0, At, B0); PG8_BAR; PG8_SCHED;
            PG8_LDB(B1, 0, 1); PG8_STAGE(PG8_SB(0, 0), b2, voffB);
            PG8_BAR; PG8_WAIT_L(0); PG8_MMA(0, 1, At, B1); PG8_BAR;
            PG8_LDA(At, 0, 1); PG8_STAGE(PG8_SA(0, 0), a2, voffA);
            PG8_BAR; PG8_WAIT_L(0); PG8_MMA(1, 0, At, B0); PG8_BAR; PG8_SCHED;
            PG8_STAGE(PG8_SB(0, 1), b2 + hstep, voffB);
            PG8_WAIT_V(6); PG8_BAR; PG8_MMA(1, 1, At, B1); PG8_BAR;
            PG8_LDB(B0, 1, 0); PG8_SCHED; PG8_LDA(At, 1, 0); PG8_STAGE(PG8_SA(0, 1), a2 + hstep, voffA);
            PG8_WAIT_L(8); PG8_BAR; PG8_WAIT_L(0); PG8_MMA(0, 0, At, B0); PG8_BAR; PG8_SCHED;
            PG8_LDB(B1, 1, 1); PG8_STAGE(PG8_SB(1, 0), b3, voffB);
            PG8_BAR; PG8_WAIT_L(0); PG8_MMA(0, 1, At, B1); PG8_BAR;
            PG8_LDA(At, 1, 1); PG8_STAGE(PG8_SA(1, 0), a3, voffA);
            PG8_BAR; PG8_WAIT_L(0); PG8_MMA(1, 0, At, B0); PG8_BAR; PG8_SCHED;
            PG8_STAGE(PG8_SB(1, 1), b3 + hstep, voffB);
            PG8_WAIT_V(6); PG8_BAR; PG8_MMA(1, 1, At, B1); PG8_BAR;
        }
        PG8_STAMP();
        if constexpr (!Epi::AFTER_DRAIN) { E(acc, cur, wr, wc, fr, fq); S.done(cur); }
        PG8_STAMP();
        if (!has_next) break;
#pragma unroll
        for (int a = 0; a < 2; ++a)
#pragma unroll
            for (int b = 0; b < 2; ++b)
#pragma unroll
                for (int m = 0; m < 4; ++m)
#pragma unroll
                    for (int n = 0; n < 2; ++n) acc[a][b][m][n] = (f32x4){0.f, 0.f, 0.f, 0.f};
        cur = nxt; cA = nA; cB = nB; ++ui;
    }
    PG8_WAIT_V(0);
    if (wr == 0) PG8_BAR;
    PG8_BAR;
    if constexpr (Epi::AFTER_DRAIN) { E.fused(acc, cur, wr, wc, fr, fq, lds, wid, lane); S.done(cur); }
    PG8_STAMP();
    if (STAMP && wid == 0) { stamps[lane] = lane < nts ? (((unsigned long long)(unsigned)ts_hi << 32) | (unsigned)ts_lo) : 0ull;
        if (lane == 62) stamps[62] = rt_entry; if (lane == 63) stamps[63] = (unsigned long long)wall_clock64(); }
#undef PG8_STAMP
#undef PG8_SA
#undef PG8_SB
#undef PG8_STAGE
#undef PG8_LDA
#undef PG8_LDB
#undef PG8_MMA
#undef PG8_WAIT_V
#undef PG8_WAIT_L
#undef PG8_BAR
#undef PG8_SCHED
}
}

using pg8::bf16_t; using pg8::bf16x8; using pg8::f32x4; using pg8::Unit; using pg8::cvt_pk_bf16;
typedef unsigned u32x2 __attribute__((ext_vector_type(2)));
typedef unsigned u32x4 __attribute__((ext_vector_type(4)));
constexpr int MPAD = 16640, MODLD = 36864, CBLD = 61440, LDS_BYTES = 143360, NPHASE = 35;
constexpr size_t ITEM_BYTES = 73792;
constexpr size_t OFF_W1 = 0, SZ_W1 = (size_t)4 * 60 * 256 * 1024 * 2;
constexpr size_t OFF_WDN = OFF_W1 + SZ_W1, SZ_WDN = (size_t)8 * 1024 * 2816 * 2;
constexpr size_t OFF_WOA = OFF_WDN + SZ_WDN, SZ_WOA = (size_t)2 * 1024 * 1024 * 2;
constexpr size_t OFF_WOB = OFF_WOA + SZ_WOA, SZ_WOB = (size_t)2 * 1024 * 2048 * 2;
constexpr size_t OFF_MOD = OFF_WOB + SZ_WOB, SZ_MOD = (size_t)136 * MODLD * 4;
constexpr size_t OFF_CB = OFF_MOD + SZ_MOD, SZ_CB = (size_t)136 * CBLD * 4;
constexpr size_t OFF_SH = OFF_CB + SZ_CB, SZ_SH = (size_t)12 * 256 * 1024 * 2;
constexpr size_t OFF_SC = OFF_SH + SZ_SH, SZ_SC = (size_t)256 * 1024 * 2;
constexpr size_t OFF_WLOG = OFF_SC + SZ_SC, SZ_WLOG = (size_t)2 * 16 * 1024 * 4;
constexpr size_t OFF_CB16 = OFF_WLOG + SZ_WLOG, SZ_CB16 = (size_t)2 * 136 * 16 * 4 + 256;
constexpr size_t OFF_X = OFF_CB16 + SZ_CB16, SZ_X = (size_t)MPAD * 1024 * 4;
constexpr size_t OFF_AN = OFF_X + SZ_X, SZ_AN = (size_t)MPAD * 1024 * 2;
constexpr size_t OFF_SSQ = OFF_AN + SZ_AN, SZ_SSQ = (size_t)MPAD * 16 * 4;
constexpr size_t OFF_LNP = OFF_SSQ + SZ_SSQ, SZ_LNP = (size_t)MPAD * 64 * 4;
constexpr size_t OFF_PROJ = OFF_LNP + SZ_LNP, SZ_PROJ = (size_t)MPAD * 4096 * 2;
constexpr size_t OFF_OAB = OFF_PROJ + SZ_PROJ, SZ_OAB = (size_t)MPAD * 2048 * 2;
constexpr size_t OFF_R1 = OFF_OAB + SZ_OAB, SZ_R1 = (size_t)2048 * ITEM_BYTES;
constexpr size_t WS_NEED = OFF_R1 + SZ_R1;
static_assert(SZ_R1 >= (size_t)MPAD * 2816 * 2 && SZ_R1 >= (size_t)36864 * 1024 * 2, "R1");
static_assert(OFF_X % 256 == 0 && OFF_R1 % 256 == 0 && OFF_PROJ % 256 == 0, "align");
constexpr size_t OUT_Y = 0, OUT_CONVP = (size_t)16512 * 1024, OUT_SP = OUT_CONVP + 2 * 8 * 3 * 3072, OUT_CONVS = OUT_SP + (size_t)2 * 8 * 8 * 128 * 128,
                 OUT_SS = OUT_CONVS + (size_t)2 * 128 * 3 * 3072, OUT_VS = OUT_SS + (size_t)2 * 128 * 8 * 128 * 128;

struct Params {
    const float *x_prompt, *x_sample, *st_conv, *st_S, *c_prompt, *c_sample, *w_ada, *b_ada, *norm_w, *w_gu, *w_down, *a_w_in, *a_w_conv, *a_log, *a_dt_bias,
        *a_w_onorm, *a_w_out, *b_w_in, *b_vnorm_w, *b_vnorm_b, *b_w_s, *b_b_s, *b_w_out, *final_w;
    float* out; unsigned char* ws; int ph_lo, ph_hi;
};

__device__ __forceinline__ float bf2f(bf16_t b) { return __uint_as_float(((unsigned)b) << 16); }
__device__ __forceinline__ bf16_t f2bf(float f) { return (bf16_t)(cvt_pk_bf16(f, 0.f) & 0xffffu); }
__device__ __forceinline__ float wsum(float v) {
#pragma unroll
    for (int o = 32; o >= 1; o >>= 1) v += __shfl_xor(v, o);
    return v; }
__device__ __forceinline__ float sigmoidf_(float x) { return __builtin_amdgcn_rcpf(1.0f + __expf(-x)); }
__device__ __forceinline__ float siluf_(float x) { return x * sigmoidf_(x); }
__device__ __forceinline__ float gelu_tanh(float x) { const float u2 = 1.5957691216f * (x + 0.044715f * x * x * x); return x * sigmoidf_(u2); }
__device__ __forceinline__ int row_b(int row) { return row < 16384 ? (row >> 11) : min(row - 16384 + 8, 135); }
__device__ __forceinline__ float row_rstd(const float* ssq, int row) {
    const f32x4* q = (const f32x4*)(ssq + (size_t)row * 16); const f32x4 a = q[0], b = q[1], c = q[2], d = q[3];
    const float s = ((a[0] + a[1]) + (a[2] + a[3])) + ((b[0] + b[1]) + (b[2] + b[3])) + ((c[0] + c[1]) + (c[2] + c[3])) + ((d[0] + d[1]) + (d[2] + d[3]));
    return rsqrtf(s * (1.0f / 1024.0f) + 1e-6f); }
__device__ __forceinline__ u32x2 pack4(f32x4 v) { u32x2 r; r.x = cvt_pk_bf16(v[0], v[1]); r.y = cvt_pk_bf16(v[2], v[3]); return r; }
__device__ __forceinline__ bf16x8 pack8(f32x4 a, f32x4 b) { u32x4 r; r.x = cvt_pk_bf16(a[0], a[1]); r.y = cvt_pk_bf16(a[2], a[3]); r.z = cvt_pk_bf16(b[0], b[1]); r.w = cvt_pk_bf16(b[2], b[3]);
    return __builtin_bit_cast(bf16x8, r); }
__device__ __forceinline__ f32x4 unpack4(u32x2 w) { f32x4 r; r[0] = __uint_as_float(w.x << 16); r[1] = __uint_as_float(w.x & 0xffff0000u); r[2] = __uint_as_float(w.y << 16); r[3] = __uint_as_float(w.y & 0xffff0000u); return r; }

struct EpiMod {
    static constexpr bool PERM = false, AFTER_DRAIN = false;
    float* C; const float* bias;
    __device__ __forceinline__ void operator()(const f32x4 (&acc)[2][2][4][2], const Unit& u, int wr, int wc, int fr, int fq) const {
#pragma unroll
        for (int ai = 0; ai < 2; ++ai)
#pragma unroll
            for (int m = 0; m < 4; ++m) { const int r = ai * 128 + wr * 64 + m * 16 + fr; if (r < 136) {
#pragma unroll
                for (int bj = 0; bj < 2; ++bj)
#pragma unroll
                    for (int n = 0; n < 2; ++n) { const int c = u.pn * 256 + bj * 128 + wc * 32 + n * 16 + 4 * fq;
                        *(f32x4*)(C + (size_t)r * MODLD + c) = acc[ai][bj][m][n] + *(const f32x4*)(bias + c); } } }
    }
};
struct EpiCb {
    static constexpr bool PERM = false, AFTER_DRAIN = false;
    float* C;
    __device__ __forceinline__ void operator()(const f32x4 (&acc)[2][2][4][2], const Unit& u, int wr, int wc, int fr, int fq) const {
#pragma unroll
        for (int ai = 0; ai < 2; ++ai)
#pragma unroll
            for (int m = 0; m < 4; ++m) { const int r = ai * 128 + wr * 64 + m * 16 + fr; if (r < 136) {
#pragma unroll
                for (int bj = 0; bj < 2; ++bj)
#pragma unroll
                    for (int n = 0; n < 2; ++n) { const int c = u.pn * 256 + bj * 128 + wc * 32 + n * 16 + 4 * fq;
                        *(f32x4*)(C + (size_t)r * CBLD + c) = acc[ai][bj][m][n]; } } }
    }
};
struct CbOrder {
    int G, c;
    __device__ bool next(int i, Unit& u) const { const int L = i * G + c; if (L >= 240) return false; const int layer = L / 60, rem = L % 60; u.pm = layer * 3 + (rem < 22 ? 0 : (rem < 38 ? 1 : 2)); u.pn = L; return true; }
    __device__ __forceinline__ void a_ready(const Unit&) const {}
    __device__ __forceinline__ void done(const Unit&) const {}
};
struct EpiSwiglu {
    static constexpr bool PERM = true, AFTER_DRAIN = false;
    bf16_t* O; const float* ssq; const float* cb;
    __device__ __forceinline__ void operator()(const f32x4 (&acc)[2][2][4][2], const Unit& u, int wr, int wc, int fr, int fq) const {
        const int cl = wc * 32 + 8 * fq;
#pragma unroll
        for (int ai = 0; ai < 2; ++ai)
#pragma unroll
            for (int m = 0; m < 4; ++m) { const int row = u.pm * 256 + ai * 128 + wr * 64 + m * 16 + fr; const int b = row_b(row); const float rs = row_rstd(ssq, row);
                const float* cbr = cb + (size_t)b * CBLD + u.pn * 256 + cl;
                const f32x4 g0 = acc[ai][0][m][0] * rs + *(const f32x4*)(cbr), g1 = acc[ai][0][m][1] * rs + *(const f32x4*)(cbr + 4);
                const f32x4 u0 = acc[ai][1][m][0] * rs + *(const f32x4*)(cbr + 128), u1 = acc[ai][1][m][1] * rs + *(const f32x4*)(cbr + 132);
                f32x4 h0, h1;
#pragma unroll
                for (int j = 0; j < 4; ++j) { h0[j] = siluf_(g0[j]) * u0[j]; h1[j] = siluf_(g1[j]) * u1[j]; }
                u32x4 w; w.x = cvt_pk_bf16(h0[0], h0[1]); w.y = cvt_pk_bf16(h0[2], h0[3]); w.z = cvt_pk_bf16(h1[0], h1[1]); w.w = cvt_pk_bf16(h1[2], h1[3]);
                *(u32x4*)(O + (size_t)row * 2816 + u.pn * 128 + cl) = w; }
    }
};
struct EpiResid {
    static constexpr bool PERM = false, AFTER_DRAIN = false;
    float* X; bf16_t* An; float* ssq; const float* mod; const float* nw; int goff, soff; float coef;
    __device__ __forceinline__ void operator()(const f32x4 (&acc)[2][2][4][2], const Unit& u, int wr, int wc, int fr, int fq) const {
#pragma unroll
        for (int ai = 0; ai < 2; ++ai)
#pragma unroll
            for (int m = 0; m < 4; ++m) { const int row = u.pm * 256 + ai * 128 + wr * 64 + m * 16 + fr; const int b = row_b(row); const float* modr = mod + (size_t)b * MODLD; float ss = 0.f;
#pragma unroll
                for (int bj = 0; bj < 2; ++bj)
#pragma unroll
                    for (int n = 0; n < 2; ++n) { const int c = u.pn * 256 + bj * 128 + wc * 32 + n * 16 + 4 * fq;
                        float* xp = X + (size_t)row * 1024 + c; const f32x4 xr = *(const f32x4*)xp; const f32x4 gt = *(const f32x4*)(modr + goff + c);
                        const f32x4 xn = xr + (gt + 1.0f) * coef * acc[ai][bj][m][n];
                        *(f32x4*)xp = xn; ss += (xn[0] * xn[0] + xn[1] * xn[1]) + (xn[2] * xn[2] + xn[3] * xn[3]);
                        if (nw) { const f32x4 sc = *(const f32x4*)(modr + soff + c); const f32x4 w = *(const f32x4*)(nw + c); *(u32x2*)(An + (size_t)row * 1024 + c) = pack4(xn * (w * (sc + 1.0f))); } }
                ss += __shfl_xor(ss, 16); ss += __shfl_xor(ss, 32);
                if (fq == 0) ssq[(size_t)row * 16 + u.pn * 4 + wc] = ss; }
    }
};
template <int ACT> struct EpiProj {
    static constexpr bool PERM = true, AFTER_DRAIN = false;
    bf16_t* O; const float* ssq; const float* cb; float* lnp;
    __device__ __forceinline__ void operator()(const f32x4 (&acc)[2][2][4][2], const Unit& u, int wr, int wc, int fr, int fq) const {
#pragma unroll
        for (int ai = 0; ai < 2; ++ai)
#pragma unroll
            for (int m = 0; m < 4; ++m) { const int row = u.pm * 256 + ai * 128 + wr * 64 + m * 16 + fr; const int b = row_b(row); const float rs = row_rstd(ssq, row); float s1 = 0.f, s2 = 0.f;
#pragma unroll
                for (int bj = 0; bj < 2; ++bj) { const int c0 = u.pn * 256 + bj * 128 + wc * 32 + 8 * fq; const float* cbr = cb + (size_t)b * CBLD + c0;
                    f32x4 v0 = acc[ai][bj][m][0] * rs + *(const f32x4*)(cbr), v1 = acc[ai][bj][m][1] * rs + *(const f32x4*)(cbr + 4);
                    if (ACT) {
#pragma unroll
                        for (int j = 0; j < 4; ++j) { v0[j] = gelu_tanh(v0[j]); v1[j] = gelu_tanh(v1[j]); }
                        s1 += ((v0[0] + v0[1]) + (v0[2] + v0[3])) + ((v1[0] + v1[1]) + (v1[2] + v1[3]));
                        s2 += ((v0[0] * v0[0] + v0[1] * v0[1]) + (v0[2] * v0[2] + v0[3] * v0[3])) + ((v1[0] * v1[0] + v1[1] * v1[1]) + (v1[2] * v1[2] + v1[3] * v1[3])); }
                    u32x4 w; w.x = cvt_pk_bf16(v0[0], v0[1]); w.y = cvt_pk_bf16(v0[2], v0[3]); w.z = cvt_pk_bf16(v1[0], v1[1]); w.w = cvt_pk_bf16(v1[2], v1[3]);
                    *(u32x4*)(O + (size_t)row * 4096 + c0) = w; }
                if (ACT) { s1 += __shfl_xor(s1, 16); s1 += __shfl_xor(s1, 32); s2 += __shfl_xor(s2, 16); s2 += __shfl_xor(s2, 32);
                    if (u.pn >= 8 && fq == 0) { float* q = lnp + ((size_t)row * 32 + (u.pn - 8) * 4 + wc) * 2; q[0] = s1; q[1] = s2; } } }
    }
};

__device__ void conv_job(const float* src, int K, int ldn, int N, int mode, bf16_t* dst, float* tile) {
    const int tid = threadIdx.x; const int nkt = K >> 6, nt = nkt * (N >> 6);
    for (int t = blockIdx.x; t < nt; t += gridDim.x) {
        const int kt = t % nkt, ntile = t / nkt, n0 = ntile * 64, k0 = kt * 64;
        { const int nl = tid & 63, kk = tid >> 6, nd = n0 + nl; const int sc = mode ? (((nd >> 7) & 1) * 2816 + (nd >> 8) * 128 + (nd & 127)) : nd;
#pragma unroll
          for (int j = 0; j < 8; ++j) tile[(kk + 8 * j) * 65 + nl] = src[(size_t)(k0 + kk + 8 * j) * ldn + sc]; }
        __syncthreads();
        { const int k2 = (tid & 31) * 2, nr = tid >> 5;
#pragma unroll
          for (int j = 0; j < 4; ++j) { const int n = nr + 16 * j; *(unsigned*)(dst + (size_t)(n0 + n) * K + k0 + k2) = cvt_pk_bf16(tile[k2 * 65 + n], tile[(k2 + 1) * 65 + n]); } }
        __syncthreads();
    }
}
__device__ void phase_convert(const Params& p, unsigned char* lds) {
    float* tile = (float*)lds; bf16_t* W1 = (bf16_t*)(p.ws + OFF_W1);
    for (int i = 0; i < 4; ++i) {
        for (int f = 0; f < 2; ++f) {
            conv_job(p.w_gu + (size_t)(i * 2 + f) * 1024 * 5632, 1024, 5632, 5632, 1, W1 + (size_t)(i * 60 + (f ? 38 : 0)) * 256 * 1024, tile);
            conv_job(p.w_down + (size_t)(i * 2 + f) * 2816 * 1024, 2816, 1024, 1024, 0, (bf16_t*)(p.ws + OFF_WDN) + (size_t)(i * 2 + f) * 1024 * 2816, tile); }
        const int li = i >> 1;
        if ((i & 1) == 0) { conv_job(p.a_w_in + (size_t)li * 1024 * 4112, 1024, 4112, 4096, 0, W1 + (size_t)(i * 60 + 22) * 256 * 1024, tile);
                            conv_job(p.a_w_out + (size_t)li * 1024 * 1024, 1024, 1024, 1024, 0, (bf16_t*)(p.ws + OFF_WOA) + (size_t)li * 1024 * 1024, tile); }
        else { conv_job(p.b_w_in + (size_t)li * 1024 * 4096, 1024, 4096, 4096, 0, W1 + (size_t)(i * 60 + 22) * 256 * 1024, tile);
               conv_job(p.b_w_out + (size_t)li * 2048 * 1024, 2048, 1024, 1024, 0, (bf16_t*)(p.ws + OFF_WOB) + (size_t)li * 1024 * 2048, tile); }
        conv_job(p.w_ada + (size_t)i * 1024 * 9216, 1024, 9216, 9216, 0, (bf16_t*)(p.ws + OFF_R1) + (size_t)i * 9216 * 1024, tile);
    }
    const int gt = blockIdx.x * 512 + threadIdx.x, gs = gridDim.x * 512;
    bf16_t* SC = (bf16_t*)(p.ws + OFF_SC);
    for (int e = gt; e < 256 * 1024; e += gs) { const int r = e >> 10, k = e & 1023; float v = 0.f; if (r < 8) v = p.c_prompt[r * 1024 + k]; else if (r < 136) v = p.c_sample[(r - 8) * 1024 + k]; SC[e] = f2bf(siluf_(v)); }
    float* WL = (float*)(p.ws + OFF_WLOG);
    for (int e = gt; e < 2 * 16 * 1024; e += gs) { const int li = e >> 14, j = (e >> 10) & 15, k = e & 1023; WL[e] = p.a_w_in[(size_t)li * 1024 * 4112 + (size_t)k * 4112 + 4096 + j]; }
}

__device__ void phase_prep0(const Params& p) {
    const int tid = threadIdx.x, lane = tid & 63, gw = blockIdx.x * 8 + (tid >> 6), nw = gridDim.x * 8;
    const float* mod = (const float*)(p.ws + OFF_MOD);
    bf16_t* SH = (bf16_t*)(p.ws + OFF_SH);
    for (int e = blockIdx.x * 512 + tid; e < 12 * 256 * 1024; e += gridDim.x * 512) { const int site = e >> 18, r = (e >> 10) & 255, k = e & 1023; const int i = site / 3, sub = site % 3;
        SH[e] = f2bf(r < 136 ? mod[(size_t)r * MODLD + i * 9216 + sub * 3072 + k] : 0.f); }
    float* X = (float*)(p.ws + OFF_X); bf16_t* An = (bf16_t*)(p.ws + OFF_AN); float* ssq = (float*)(p.ws + OFF_SSQ);
    for (int row = gw; row < MPAD; row += nw) {
        const float* src = row < 16384 ? p.x_prompt + (size_t)row * 1024 : (row < 16512 ? p.x_sample + (size_t)(row - 16384) * 1024 : nullptr);
        const int b = row_b(row); const float* modr = mod + (size_t)b * MODLD; float ss = 0.f;
#pragma unroll
        for (int j = 0; j < 4; ++j) { const int k = j * 256 + lane * 4; f32x4 x = {0.f, 0.f, 0.f, 0.f}; if (src) x = *(const f32x4*)(src + k);
            *(f32x4*)(X + (size_t)row * 1024 + k) = x; ss += (x[0] * x[0] + x[1] * x[1]) + (x[2] * x[2] + x[3] * x[3]);
            const f32x4 sc = *(const f32x4*)(modr + 1024 + k), w = *(const f32x4*)(p.norm_w + k); *(u32x2*)(An + (size_t)row * 1024 + k) = pack4(x * (w * (sc + 1.0f))); }
        ss = wsum(ss); if (lane < 16) ssq[(size_t)row * 16 + lane] = lane == 0 ? ss : 0.f;
    }
    const float* WL = (const float*)(p.ws + OFF_WLOG); float* cb16 = (float*)(p.ws + OFF_CB16);
    for (int t = gw; t < 2 * 136; t += nw) { const int li = t / 136, b = t % 136; const float* sh = mod + (size_t)b * MODLD + (2 * li) * 9216 + 3072;
        for (int j = 0; j < 16; ++j) { const float* w = WL + (size_t)(li * 16 + j) * 1024; float s = 0.f;
            for (int k = lane; k < 1024; k += 64) s += sh[k] * w[k];
            s = wsum(s); if (lane == 0) cb16[t * 16 + j] = s; } }
}

__device__ void phase_final(const Params& p) {
    const int tid = threadIdx.x, lane = tid & 63, gw = blockIdx.x * 8 + (tid >> 6), nw = gridDim.x * 8;
    const float* X = (const float*)(p.ws + OFF_X); const float* ssq = (const float*)(p.ws + OFF_SSQ);
    for (int row = gw; row < 16512; row += nw) { const float rs = row_rstd(ssq, row);
#pragma unroll
        for (int j = 0; j < 4; ++j) { const int k = j * 256 + lane * 4; const f32x4 x = *(const f32x4*)(X + (size_t)row * 1024 + k), w = *(const f32x4*)(p.final_w + k);
            *(f32x4*)(p.out + OUT_Y + (size_t)row * 1024 + k) = x * rs * w; } }
}

__device__ void prep_phase(const Params& p, int li, unsigned char* lds) {
    const int tid = threadIdx.x, lane = tid & 63, wv = __builtin_amdgcn_readfirstlane(tid >> 6), fr = lane & 15, fq = lane >> 4;
    float* MT = (float*)lds; float* sm = (float*)(lds + 17408); bf16_t* kn = (bf16_t*)(lds + 19456); bf16_t* qn = (bf16_t*)(lds + 36864); bf16_t* at = (bf16_t*)(lds + 54272); float* solf = (float*)(lds + 63488);
    const bf16_t* PROJ = (const bf16_t*)(p.ws + OFF_PROJ); const bf16_t* An = (const bf16_t*)(p.ws + OFF_AN); const float* ssq = (const float*)(p.ws + OFF_SSQ);
    const float* WL = (const float*)(p.ws + OFF_WLOG); const float* cb16 = (const float*)(p.ws + OFF_CB16);
    const float* wconv = p.a_w_conv + (size_t)li * 4 * 3072;
    for (int item = blockIdx.x; item < 2048; item += gridDim.x) {
        const int b = item >> 8, n = (item >> 3) & 31, h = item & 7; const int row0 = b * 2048 + n * 64;
        unsigned char* dst = p.ws + OFF_R1 + (size_t)item * ITEM_BYTES;
        for (int e = tid; e < 6144; e += 512) { const int tok = e / 96, c4 = e % 96, seg = c4 >> 5, ch = (c4 & 31) * 4, col = seg * 1024 + h * 128 + ch;
            f32x4 a = {0.f, 0.f, 0.f, 0.f};
#pragma unroll
            for (int j = 0; j < 4; ++j) { const int pos = n * 64 + tok - 3 + j; if (pos >= 0) { const u32x2 xw = *(const u32x2*)(PROJ + (size_t)(b * 2048 + pos) * 4096 + col); a += unpack4(xw) * *(const f32x4*)(wconv + j * 3072 + col); } }
            f32x4 s;
#pragma unroll
            for (int j = 0; j < 4; ++j) s[j] = siluf_(a[j]);
            float ss = (s[0] * s[0] + s[1] * s[1]) + (s[2] * s[2] + s[3] * s[3]);
#pragma unroll
            for (int o = 1; o <= 16; o <<= 1) ss += __shfl_xor(ss, o);
            const float rn = rsqrtf(ss + 1e-6f);
            if (seg == 0) *(u32x2*)(qn + tok * 136 + ch) = pack4(s * (rn * 0.08838834764831845f));
            else if (seg == 1) *(u32x2*)(kn + tok * 136 + ch) = pack4(s * rn);
            else *(f32x4*)(solf + tok * 260 + ch) = s; }
        if (n == 31) for (int e = tid; e < 3 * 384; e += 512) { const int r = e / 384, cc = e % 384, col = (cc >> 7) * 1024 + h * 128 + (cc & 127);
            p.out[OUT_CONVP + ((size_t)(li * 8 + b) * 3 + r) * 3072 + col] = bf2f(PROJ[(size_t)(b * 2048 + 2045 + r) * 4096 + col]); }
        { const int tok = tid >> 3, part = tid & 7, row = row0 + tok; const bf16_t* ar = An + (size_t)row * 1024 + part * 128;
          const float* w1 = WL + (size_t)(li * 16 + h) * 1024 + part * 128; const float* w2 = WL + (size_t)(li * 16 + 8 + h) * 1024 + part * 128; float s1 = 0.f, s2 = 0.f;
#pragma unroll 4
          for (int kk = 0; kk < 16; ++kk) { const u32x4 xw = *(const u32x4*)(ar + kk * 8); const f32x4 x0 = unpack4((u32x2){xw.x, xw.y}), x1 = unpack4((u32x2){xw.z, xw.w});
              const f32x4 a0 = *(const f32x4*)(w1 + kk * 8), a1 = *(const f32x4*)(w1 + kk * 8 + 4), c0 = *(const f32x4*)(w2 + kk * 8), c1 = *(const f32x4*)(w2 + kk * 8 + 4);
#pragma unroll
              for (int j = 0; j < 4; ++j) { s1 += x0[j] * a0[j] + x1[j] * a1[j]; s2 += x0[j] * c0[j] + x1[j] * c1[j]; } }
          s1 += __shfl_xor(s1, 1); s1 += __shfl_xor(s1, 2); s1 += __shfl_xor(s1, 4); s2 += __shfl_xor(s2, 1); s2 += __shfl_xor(s2, 2); s2 += __shfl_xor(s2, 4);
          if (part == 0) { const float rs = row_rstd(ssq, row); const float bl = rs * s1 + cb16[(li * 136 + b) * 16 + h], al = rs * s2 + cb16[(li * 136 + b) * 16 + 8 + h] + p.a_dt_bias[li * 8 + h];
              const float sp = fmaxf(al, 0.f) + log1pf(__expf(-fabsf(al))); sm[tok] = sigmoidf_(bl); sm[64 + tok] = -__expf(p.a_log[li * 8 + h]) * sp; } }
        __syncthreads();
        if (wv == 0) { float d = sm[64 + lane];
#pragma unroll
            for (int o = 1; o < 64; o <<= 1) { const float t = __shfl_up(d, o); if (lane >= o) d += t; }
            sm[128 + lane] = d; sm[192 + lane] = __expf(d); }
        __syncthreads();
        { const int gram = wv >> 2, i = wv & 3; const bf16_t* src = gram ? qn : kn; bf16x8 a[4];
#pragma unroll
          for (int t = 0; t < 4; ++t) a[t] = *(const bf16x8*)(src + (16 * i + fr) * 136 + 32 * t + 8 * fq);
          for (int j = 0; j < 4; ++j) { f32x4 acc = {0.f, 0.f, 0.f, 0.f};
              if (j <= i) {
#pragma unroll
                  for (int t = 0; t < 4; ++t) { const bf16x8 bb = *(const bf16x8*)(kn + (16 * j + fr) * 136 + 32 * t + 8 * fq); acc = __builtin_amdgcn_mfma_f32_16x16x32_bf16(a[t], bb, acc, 0, 0, 0); } }
              const int s = 16 * j + fr; const float ds = sm[128 + s];
#pragma unroll
              for (int idx = 0; idx < 4; ++idx) { const int c = 16 * i + 4 * fq + idx; const float gam = __expf(sm[128 + c] - ds);
                  if (gram == 0) MT[s * 68 + c] = (c > s) ? sm[c] * acc[idx] * gam : 0.f;
                  else at[c * 72 + s] = f2bf((c >= s) ? acc[idx] * gam : 0.f); } } }
        __syncthreads();
        if (wv < 4) {
            const int col = tid; const bool isv = wv < 2;
#pragma unroll
            for (int ib = 0; ib < 4; ++ib) { float acc[16];
#pragma unroll
                for (int r = 0; r < 16; ++r) { const int i = 16 * ib + r; const float bi = sm[i]; const float rv = solf[i * 260 + col], rk_ = bf2f(kn[i * 136 + (col & 127)]) * sm[192 + i]; acc[r] = (isv ? rv : rk_) * bi; }
                for (int j = 0; j < 16 * ib; ++j) { const float sj = solf[j * 260 + col]; const f32x4 m0 = *(const f32x4*)(MT + j * 68 + 16 * ib), m1 = *(const f32x4*)(MT + j * 68 + 16 * ib + 4), m2 = *(const f32x4*)(MT + j * 68 + 16 * ib + 8), m3 = *(const f32x4*)(MT + j * 68 + 16 * ib + 12);
#pragma unroll
                    for (int r = 0; r < 4; ++r) { acc[r] -= m0[r] * sj; acc[4 + r] -= m1[r] * sj; acc[8 + r] -= m2[r] * sj; acc[12 + r] -= m3[r] * sj; } }
#pragma unroll
                for (int r = 0; r < 16; ++r) {
#pragma unroll
                    for (int q = 0; q < r; ++q) acc[r] -= MT[(16 * ib + q) * 68 + 16 * ib + r] * acc[q];
                    solf[(16 * ib + r) * 260 + col] = acc[r]; } }
        } else {
            const int t2 = tid - 256; const float dl = sm[128 + 63];
            for (int e = t2; e < 1024; e += 256) { const int ln = e & 63, f = e >> 6, i = f >> 2, t = f & 3, r_ = ln & 15, q_ = ln >> 4; const int c = 16 * i + r_; const float sc = sm[192 + c];
                const u32x2 lo = *(const u32x2*)(qn + c * 136 + 32 * t + 4 * q_), hi = *(const u32x2*)(qn + c * 136 + 32 * t + 16 + 4 * q_);
                const u32x2 a = pack4(unpack4(lo) * sc), bq = pack4(unpack4(hi) * sc); *(u32x4*)(dst + 16384 + (size_t)e * 16) = (u32x4){a.x, a.y, bq.x, bq.y}; }
            for (int e = t2; e < 1024; e += 256) { const int ln = e & 63, f = e >> 6, j = f >> 1, tt = f & 1, r_ = ln & 15, q_ = ln >> 4; const int kd = 16 * j + r_; f32x4 lo, hi;
#pragma unroll
                for (int s = 0; s < 4; ++s) { const int c0 = 32 * tt + 4 * q_ + s, c1 = c0 + 16; lo[s] = bf2f(kn[c0 * 136 + kd]) * __expf(dl - sm[128 + c0]); hi[s] = bf2f(kn[c1 * 136 + kd]) * __expf(dl - sm[128 + c1]); }
                const u32x2 a = pack4(lo), bq = pack4(hi); *(u32x4*)(dst + 32768 + (size_t)e * 16) = (u32x4){a.x, a.y, bq.x, bq.y}; }
            for (int e = t2; e < 512; e += 256) { const int ln = e & 63, f = e >> 6, i = f >> 1, tt = f & 1, r_ = ln & 15, q_ = ln >> 4; const int c = 16 * i + r_;
                const u32x2 lo = *(const u32x2*)(at + c * 72 + 32 * tt + 4 * q_), hi = *(const u32x2*)(at + c * 72 + 32 * tt + 16 + 4 * q_);
                *(u32x4*)(dst + 49152 + (size_t)e * 16) = (u32x4){lo.x, lo.y, hi.x, hi.y}; }
            if (t2 == 0) *(float*)(dst + 73728) = __expf(dl);
        }
        __syncthreads();
        for (int e = tid; e < 1024; e += 512) { const int ln = e & 63, f = e >> 6, i = f >> 2, t = f & 3, r_ = ln & 15, q_ = ln >> 4; const int c = 16 * i + r_;
            const u32x2 lo = pack4(*(const f32x4*)(solf + c * 260 + 128 + 32 * t + 4 * q_)), hi = pack4(*(const f32x4*)(solf + c * 260 + 128 + 32 * t + 16 + 4 * q_));
            *(u32x4*)(dst + (size_t)e * 16) = (u32x4){lo.x, lo.y, hi.x, hi.y}; }
        for (int e = tid; e < 2048; e += 512) { const int ln = e & 63, f = e >> 6, i = f >> 3, w_ = f & 7, r_ = ln & 15, q_ = ln >> 4; const int vcol = 16 * w_ + r_, c0 = 16 * i + 4 * q_;
            *(u32x2*)(dst + 57344 + (size_t)e * 8) = pack4((f32x4){solf[c0 * 260 + vcol], solf[(c0 + 1) * 260 + vcol], solf[(c0 + 2) * 260 + vcol], solf[(c0 + 3) * 260 + vcol]}); }
        __syncthreads();
    }
}

__device__ void scan_block(const Params& p, int li, int bh, unsigned char* lds) {
    const int tid = threadIdx.x, lane = tid & 63, wv = __builtin_amdgcn_readfirstlane(tid >> 6), fr = lane & 15, fq = lane >> 4; const int b = bh >> 3, h = bh & 7;
    float* red = (float*)(lds + 114688);
    const bf16_t* PROJ = (const bf16_t*)(p.ws + OFF_PROJ); bf16_t* OA = (bf16_t*)(p.ws + OFF_OAB);
    const unsigned char* base = p.ws + OFF_R1 + (size_t)((b * 32) * 8 + h) * ITEM_BYTES; const size_t cstride = 8 * ITEM_BYTES;
    f32x4 S[8];
#pragma unroll
    for (int j = 0; j < 8; ++j) S[j] = (f32x4){0.f, 0.f, 0.f, 0.f};
    u32x4 st[7]; u32x2 ucur[4], unext[4]; float elc, eln;
#pragma unroll
    for (int j = 0; j < 7; ++j) st[j] = *(const u32x4*)(base + (size_t)(j * 512 + tid) * 16);
#pragma unroll
    for (int i = 0; i < 4; ++i) ucur[i] = *(const u32x2*)(base + 57344 + (size_t)((i * 8 + wv) * 64 + lane) * 8);
    elc = *(const float*)(base + 73728);
#pragma unroll
    for (int j = 0; j < 7; ++j) *(u32x4*)(lds + (size_t)(j * 512 + tid) * 16) = st[j];
    __syncthreads();
    const float wn = p.a_w_onorm[li * 128 + 16 * wv + fr];
    for (int n = 0; n < 32; ++n) {
        const unsigned char* nb = base + (size_t)(n + 1) * cstride;
        if (n + 1 < 32) {
#pragma unroll
            for (int j = 0; j < 7; ++j) st[j] = *(const u32x4*)(nb + (size_t)(j * 512 + tid) * 16);
#pragma unroll
            for (int i = 0; i < 4; ++i) unext[i] = *(const u32x2*)(nb + 57344 + (size_t)((i * 8 + wv) * 64 + lane) * 8);
            eln = *(const float*)(nb + 73728);
        }
        const unsigned char* buf = lds + (size_t)(n & 1) * 57344;
        bf16x8 Sb[4];
#pragma unroll
        for (int t = 0; t < 4; ++t) Sb[t] = pack8(S[2 * t], S[2 * t + 1]);
        f32x4 vnew[4];
#pragma unroll
        for (int i = 0; i < 4; ++i) { f32x4 acc = {0.f, 0.f, 0.f, 0.f};
#pragma unroll
            for (int t = 0; t < 4; ++t) { const bf16x8 wf = *(const bf16x8*)(buf + (size_t)((i * 4 + t) * 64 + lane) * 16); acc = __builtin_amdgcn_mfma_f32_16x16x32_bf16(wf, Sb[t], acc, 0, 0, 0); }
            vnew[i] = unpack4(ucur[i]) - acc; }
        bf16x8 vb[2];
#pragma unroll
        for (int t = 0; t < 2; ++t) vb[t] = pack8(vnew[2 * t], vnew[2 * t + 1]);
        f32x4 o[4];
#pragma unroll
        for (int i = 0; i < 4; ++i) { f32x4 acc = {0.f, 0.f, 0.f, 0.f};
#pragma unroll
            for (int t = 0; t < 4; ++t) { const bf16x8 qf = *(const bf16x8*)(buf + 16384 + (size_t)((i * 4 + t) * 64 + lane) * 16); acc = __builtin_amdgcn_mfma_f32_16x16x32_bf16(qf, Sb[t], acc, 0, 0, 0); }
#pragma unroll
            for (int t = 0; t < 2; ++t) { const bf16x8 af = *(const bf16x8*)(buf + 49152 + (size_t)((i * 2 + t) * 64 + lane) * 16); acc = __builtin_amdgcn_mfma_f32_16x16x32_bf16(af, vb[t], acc, 0, 0, 0); }
            o[i] = acc; }
#pragma unroll
        for (int j = 0; j < 8; ++j) { f32x4 acc = S[j] * elc;
#pragma unroll
            for (int t = 0; t < 2; ++t) { const bf16x8 kf = *(const bf16x8*)(buf + 32768 + (size_t)((j * 2 + t) * 64 + lane) * 16); acc = __builtin_amdgcn_mfma_f32_16x16x32_bf16(kf, vb[t], acc, 0, 0, 0); }
            S[j] = acc; }
        float* rd = red + (n & 1) * 512;
#pragma unroll
        for (int i = 0; i < 4; ++i)
#pragma unroll
            for (int idx = 0; idx < 4; ++idx) { float q = o[i][idx] * o[i][idx]; q += __shfl_xor(q, 1); q += __shfl_xor(q, 2); q += __shfl_xor(q, 4); q += __shfl_xor(q, 8);
                if (fr == 0) rd[(16 * i + 4 * fq + idx) * 8 + wv] = q; }
        if (n + 1 < 32) { unsigned char* ob = lds + (size_t)((n + 1) & 1) * 57344;
#pragma unroll
            for (int j = 0; j < 7; ++j) *(u32x4*)(ob + (size_t)(j * 512 + tid) * 16) = st[j]; }
        __syncthreads();
#pragma unroll
        for (int i = 0; i < 4; ++i)
#pragma unroll
            for (int idx = 0; idx < 4; ++idx) { const int c = 16 * i + 4 * fq + idx; const f32x4 r0 = *(const f32x4*)(rd + c * 8), r1 = *(const f32x4*)(rd + c * 8 + 4);
                const float ssq_ = ((r0[0] + r0[1]) + (r0[2] + r0[3])) + ((r1[0] + r1[1]) + (r1[2] + r1[3])); const float rs = rsqrtf(ssq_ * (1.0f / 128.0f) + 1e-6f);
                const size_t row = (size_t)b * 2048 + n * 64 + c; const float z = bf2f(PROJ[row * 4096 + 3072 + h * 128 + 16 * wv + fr]);
                OA[row * 1024 + h * 128 + 16 * wv + fr] = f2bf(o[i][idx] * rs * wn * siluf_(z)); }
        if (n + 1 < 32) {
#pragma unroll
            for (int i = 0; i < 4; ++i) ucur[i] = unext[i];
            elc = eln; }
    }
    float* So = p.out + OUT_SP + (size_t)((li * 8 + b) * 8 + h) * 16384;
#pragma unroll
    for (int j = 0; j < 8; ++j)
#pragma unroll
        for (int idx = 0; idx < 4; ++idx) So[(16 * j + 4 * fq + idx) * 128 + 16 * wv + fr] = S[j][idx];
    __syncthreads();
}

__device__ void sampleA_item(const Params& p, int li, int sb, int h, unsigned char* lds) {
    const int tid = threadIdx.x, lane = tid & 63, wv = __builtin_amdgcn_readfirstlane(tid >> 6); const int row = 16384 + sb;
    float* qkv = (float*)lds; float* redA = qkv + 384; float* red1 = redA + 64; float* red2 = red1 + 512; float* scal = red2 + 512;
    const bf16_t* PROJ = (const bf16_t*)(p.ws + OFF_PROJ); const bf16_t* An = (const bf16_t*)(p.ws + OFF_AN); bf16_t* OA = (bf16_t*)(p.ws + OFF_OAB);
    if (tid < 384) { const int seg = tid >> 7, ch = tid & 127, col = seg * 1024 + h * 128 + ch; const float* stc = p.st_conv + (size_t)(li * 128 + sb) * 3 * 3072 + col;
        const float s0 = stc[0], s1 = stc[3072], s2 = stc[6144], xn = bf2f(PROJ[(size_t)row * 4096 + col]); const float* w = p.a_w_conv + (size_t)li * 4 * 3072 + col;
        qkv[tid] = siluf_(s0 * w[0] + s1 * w[3072] + s2 * w[6144] + xn * w[9216]);
        float* co = p.out + OUT_CONVS + (size_t)(li * 128 + sb) * 3 * 3072 + col; co[0] = s1; co[3072] = s2; co[6144] = xn; }
    { const float* WL = (const float*)(p.ws + OFF_WLOG); const int k = tid * 2; const float x0 = bf2f(An[(size_t)row * 1024 + k]), x1 = bf2f(An[(size_t)row * 1024 + k + 1]);
      const float* w1 = WL + (size_t)(li * 16 + h) * 1024 + k; const float* w2 = WL + (size_t)(li * 16 + 8 + h) * 1024 + k;
      float s1 = x0 * w1[0] + x1 * w1[1], s2 = x0 * w2[0] + x1 * w2[1]; s1 = wsum(s1); s2 = wsum(s2); if (lane == 0) { redA[wv] = s1; redA[8 + wv] = s2; } }
    __syncthreads();
    if (wv == 0) { float q = qkv[lane] * qkv[lane] + qkv[64 + lane] * qkv[64 + lane]; q = wsum(q); if (lane == 0) scal[0] = rsqrtf(q + 1e-6f) * 0.08838834764831845f; }
    if (wv == 1) { float q = qkv[128 + lane] * qkv[128 + lane] + qkv[192 + lane] * qkv[192 + lane]; q = wsum(q); if (lane == 0) scal[1] = rsqrtf(q + 1e-6f); }
    if (tid == 128) { float s1 = 0.f, s2 = 0.f; for (int j = 0; j < 8; ++j) { s1 += redA[j]; s2 += redA[8 + j]; }
        const float rs = row_rstd((const float*)(p.ws + OFF_SSQ), row); const float* cb16 = (const float*)(p.ws + OFF_CB16) + (size_t)(li * 136 + 8 + sb) * 16;
        const float bl = rs * s1 + cb16[h], al = rs * s2 + cb16[8 + h] + p.a_dt_bias[li * 8 + h]; const float sp = fmaxf(al, 0.f) + log1pf(__expf(-fabsf(al)));
        scal[2] = sigmoidf_(bl); scal[3] = __expf(-__expf(p.a_log[li * 8 + h]) * sp); }
    __syncthreads();
    const float rq = scal[0], rk = scal[1], beta = scal[2], eg = scal[3];
    const int v = tid & 127, kq = tid >> 7;
    const float* S0 = p.st_S + ((size_t)((li * 128 + sb) * 8 + h) * 128 + kq * 32) * 128 + v; float s[32]; float part = 0.f;
#pragma unroll
    for (int kk = 0; kk < 32; ++kk) { s[kk] = S0[kk * 128]; part += s[kk] * (qkv[128 + kq * 32 + kk] * rk); }
    red1[kq * 128 + v] = part;
    __syncthreads();
    const float kv = (red1[v] + red1[128 + v]) + (red1[256 + v] + red1[384 + v]); const float vnew = beta * (qkv[256 + v] - eg * kv);
    float* So = p.out + OUT_SS + ((size_t)((li * 128 + sb) * 8 + h) * 128 + kq * 32) * 128 + v; float po = 0.f;
#pragma unroll
    for (int kk = 0; kk < 32; ++kk) { const float sn = eg * s[kk] + (qkv[128 + kq * 32 + kk] * rk) * vnew; So[kk * 128] = sn; po += sn * (qkv[kq * 32 + kk] * rq); }
    red2[kq * 128 + v] = po;
    __syncthreads();
    float o = 0.f;
    if (tid < 128) { o = (red2[v] + red2[128 + v]) + (red2[256 + v] + red2[384 + v]); const float q = wsum(o * o); if (lane == 0) scal[4 + wv] = q; }
    __syncthreads();
    if (tid < 128) { const float rs = rsqrtf((scal[4] + scal[5]) * (1.0f / 128.0f) + 1e-6f); const float z = bf2f(PROJ[(size_t)row * 4096 + 3072 + h * 128 + v]);
        OA[(size_t)row * 1024 + h * 128 + v] = f2bf(o * rs * p.a_w_onorm[li * 128 + v] * siluf_(z)); }
    __syncthreads();
}

__device__ void mixB_phase(const Params& p, int li, unsigned char* lds) {
    const int tid = threadIdx.x, lane = tid & 63, wv = __builtin_amdgcn_readfirstlane(tid >> 6), fr = lane & 15, fq = lane >> 4;
    bf16_t* vT = (bf16_t*)lds; float* stt = (float*)(lds + 69632);
    const bf16_t* UV = (const bf16_t*)(p.ws + OFF_PROJ); bf16_t* OB = (bf16_t*)(p.ws + OFF_OAB); const float* lnp = (const float*)(p.ws + OFF_LNP);
    const float* vw = p.b_vnorm_w + li * 2048; const float* vbias = p.b_vnorm_b + li * 2048;
    { const int gw = blockIdx.x * 8 + wv; if (gw < 128) { const int row = 16384 + gw; float s1 = 0.f, s2 = 0.f; if (lane < 32) { s1 = lnp[((size_t)row * 32 + lane) * 2]; s2 = lnp[((size_t)row * 32 + lane) * 2 + 1]; }
        s1 = wsum(s1); s2 = wsum(s2); const float mean = s1 * (1.0f / 2048.0f), rstd = rsqrtf(fmaxf(s2 * (1.0f / 2048.0f) - mean * mean, 0.f) + 1e-6f);
#pragma unroll
        for (int jj = 0; jj < 4; ++jj) { const int c = (jj * 64 + lane) * 8, g = c >> 8; const u32x4 vw4 = *(const u32x4*)(UV + (size_t)row * 4096 + 2048 + c), uw4 = *(const u32x4*)(UV + (size_t)row * 4096 + c);
            const f32x4 v0 = unpack4((u32x2){vw4.x, vw4.y}), v1 = unpack4((u32x2){vw4.z, vw4.w}), u0 = unpack4((u32x2){uw4.x, uw4.y}), u1 = unpack4((u32x2){uw4.z, uw4.w});
            const f32x4 n0 = (v0 - mean) * rstd * *(const f32x4*)(vw + c) + *(const f32x4*)(vbias + c), n1 = (v1 - mean) * rstd * *(const f32x4*)(vw + c + 4) + *(const f32x4*)(vbias + c + 4);
            float* vo = p.out + OUT_VS + (size_t)(li * 128 + gw) * 2048 + c; *(f32x4*)vo = n0; *(f32x4*)(vo + 4) = n1;
            const float w00 = p.b_w_s[(size_t)(li * 8 + g) * 16384], bs0 = p.b_b_s[(li * 8 + g) * 128];
            const f32x4 m0 = n0 * w00 + bs0, m1 = n1 * w00 + bs0; const u32x2 a = pack4(u0 * m0), bq = pack4(u1 * m1);
            *(u32x4*)(OB + (size_t)row * 2048 + c) = (u32x4){a.x, a.y, bq.x, bq.y}; } } }
    for (int item = blockIdx.x; item < 1024; item += gridDim.x) {
        const int b = item >> 7, n = (item >> 3) & 15, g = item & 7; const int row0 = b * 2048 + n * 128;
        if (tid < 128) { const float* q = lnp + (size_t)(row0 + tid) * 64; float s1 = 0.f, s2 = 0.f;
#pragma unroll
            for (int j = 0; j < 16; ++j) { const f32x4 t = *(const f32x4*)(q + 4 * j); s1 += t[0] + t[2]; s2 += t[1] + t[3]; }
            const float mean = s1 * (1.0f / 2048.0f); stt[tid] = mean; stt[128 + tid] = rsqrtf(fmaxf(s2 * (1.0f / 2048.0f) - mean * mean, 0.f) + 1e-6f); }
        __syncthreads();
#pragma unroll 2
        for (int j = 0; j < 8; ++j) { const int e = tid + 512 * j, s = e >> 5, d8 = (e & 31) * 8; const u32x4 xw = *(const u32x4*)(UV + (size_t)(row0 + s) * 4096 + 2048 + g * 256 + d8);
            const f32x4 x0 = unpack4((u32x2){xw.x, xw.y}), x1 = unpack4((u32x2){xw.z, xw.w}); const float mean = stt[s], rstd = stt[128 + s];
            const f32x4 n0 = (x0 - mean) * rstd * *(const f32x4*)(vw + g * 256 + d8) + *(const f32x4*)(vbias + g * 256 + d8), n1 = (x1 - mean) * rstd * *(const f32x4*)(vw + g * 256 + d8 + 4) + *(const f32x4*)(vbias + g * 256 + d8 + 4);
#pragma unroll
            for (int jj = 0; jj < 4; ++jj) { vT[(d8 + jj) * 136 + s] = f2bf(n0[jj]); vT[(d8 + 4 + jj) * 136 + s] = f2bf(n1[jj]); } }
        __syncthreads();
        { const int i = wv; f32x4 acc[16];
#pragma unroll
          for (int j = 0; j < 16; ++j) acc[j] = (f32x4){0.f, 0.f, 0.f, 0.f};
          const int t = 16 * i + fr; const float* wsr = p.b_w_s + ((size_t)(li * 8 + g) * 128 + t) * 128;
          for (int ks = 0; ks <= (i >> 1); ++ks) { const int s0 = 32 * ks + 8 * fq; f32x4 w0 = *(const f32x4*)(wsr + s0), w1 = *(const f32x4*)(wsr + s0 + 4);
#pragma unroll
              for (int jj = 0; jj < 4; ++jj) { if (s0 + jj > t) w0[jj] = 0.f; if (s0 + 4 + jj > t) w1[jj] = 0.f; }
              const bf16x8 wf = pack8(w0, w1);
#pragma unroll
              for (int j = 0; j < 16; ++j) { const bf16x8 vfr = *(const bf16x8*)(vT + (16 * j + fr) * 136 + 32 * ks + 8 * fq); acc[j] = __builtin_amdgcn_mfma_f32_16x16x32_bf16(vfr, wf, acc[j], 0, 0, 0); } }
          const float bias = p.b_b_s[(li * 8 + g) * 128 + t]; const size_t row = (size_t)row0 + t;
#pragma unroll
          for (int j = 0; j < 16; ++j) { const int d0 = 16 * j + 4 * fq; const f32x4 uu = unpack4(*(const u32x2*)(UV + row * 4096 + g * 256 + d0));
              *(u32x2*)(OB + row * 2048 + g * 256 + d0) = pack4(uu * (acc[j] + bias)); } }
        __syncthreads();
    }
}

__host__ __device__ __forceinline__ void decode_phase(int ph, int& kind, int& layer, int& f) {
    layer = 0; f = 0;
    if (ph < 4) { kind = ph; return; }
    if (ph == NPHASE - 1) { kind = 11; return; }
    int q = ph - 4, s; if (q < 8) { layer = 0; s = q; } else if (q < 15) { layer = 1; s = q - 8; } else if (q < 23) { layer = 2; s = q - 15; } else { layer = 3; s = q - 23; }
    if ((layer & 1) == 0) { f = s >= 6; kind = (s == 0 || s == 6) ? 4 : (s == 1 || s == 7) ? 5 : (s == 2) ? 6 : (s == 3) ? 7 : (s == 4) ? 8 : 10; }
    else { f = s >= 5; kind = (s == 0 || s == 5) ? 4 : (s == 1 || s == 6) ? 5 : (s == 2) ? 6 : (s == 3) ? 9 : 10; }
}
template <int KIND> __device__ __forceinline__ void run_kind(const Params& p, int layer, int f, unsigned char* lds) {
    PG8_LAS unsigned char* ldsl = (PG8_LAS unsigned char*)lds;
    unsigned char* ws = p.ws; const int G = gridDim.x, cid = blockIdx.x;
    bf16_t* W1 = (bf16_t*)(ws + OFF_W1); float* mod = (float*)(ws + OFF_MOD); float* cb = (float*)(ws + OFF_CB); float* X = (float*)(ws + OFF_X); bf16_t* An = (bf16_t*)(ws + OFF_AN);
    float* ssq = (float*)(ws + OFF_SSQ); bf16_t* ACTB = (bf16_t*)(ws + OFF_R1); bf16_t* PROJ = (bf16_t*)(ws + OFF_PROJ); bf16_t* OAB = (bf16_t*)(ws + OFF_OAB);
    const int li = layer >> 1;
    if constexpr (KIND == 0) { phase_convert(p, lds); }
    else if constexpr (KIND == 1) { pg8::Gemm g{(const bf16_t*)(ws + OFF_SC), (const bf16_t*)(ws + OFF_R1), 256, MODLD, 1024}; pg8::StaticOrder S; S.init(256, MODLD, G, cid); EpiMod E{mod, p.b_ada};
        pg8::gemm_phase<EpiMod, pg8::StaticOrder>(ldsl, g, S, E, nullptr); }
    else if constexpr (KIND == 2) { phase_prep0(p); }
    else if constexpr (KIND == 3) { pg8::Gemm g{(const bf16_t*)(ws + OFF_SH), W1, 3072, CBLD, 1024}; CbOrder S{G, cid}; EpiCb E{cb};
        pg8::gemm_phase<EpiCb, CbOrder>(ldsl, g, S, E, nullptr); }
    else if constexpr (KIND == 4) { const int t0 = layer * 60 + (f ? 38 : 0); pg8::Gemm g{An, W1 + (size_t)t0 * 256 * 1024, MPAD, 5632, 1024}; pg8::StaticOrder S; S.init(MPAD, 5632, G, cid);
        EpiSwiglu E{ACTB, ssq, cb + (size_t)t0 * 256}; pg8::gemm_phase<EpiSwiglu, pg8::StaticOrder>(ldsl, g, S, E, nullptr); }
    else if constexpr (KIND == 5 || KIND == 10) {
        pg8::Gemm g; EpiResid E; E.X = X; E.An = An; E.ssq = ssq; E.mod = mod;
        if (KIND == 5) { g = pg8::Gemm{ACTB, (const bf16_t*)(ws + OFF_WDN) + (size_t)(layer * 2 + f) * 1024 * 2816, MPAD, 1024, 2816}; E.goff = layer * 9216 + (f ? 2 : 0) * 3072 + 2048; E.coef = 0.5f;
            if (!f) { E.nw = p.norm_w + (layer * 3 + 1) * 1024; E.soff = layer * 9216 + 3072 + 1024; }
            else if (layer < 3) { E.nw = p.norm_w + ((layer + 1) * 3) * 1024; E.soff = (layer + 1) * 9216 + 1024; }
            else { E.nw = nullptr; E.soff = 0; } }
        else { g = pg8::Gemm{OAB, (layer & 1) ? (const bf16_t*)(ws + OFF_WOB) + (size_t)li * 1024 * 2048 : (const bf16_t*)(ws + OFF_WOA) + (size_t)li * 1024 * 1024, MPAD, 1024, (layer & 1) ? 2048 : 1024};
            E.goff = layer * 9216 + 3072 + 2048; E.coef = 1.0f; E.nw = p.norm_w + (layer * 3 + 2) * 1024; E.soff = layer * 9216 + 2 * 3072 + 1024; }
        pg8::StaticOrder S; S.init(MPAD, 1024, G, cid); pg8::gemm_phase<EpiResid, pg8::StaticOrder>(ldsl, g, S, E, nullptr); }
    else if constexpr (KIND == 6) { const int t0 = layer * 60 + 22; pg8::Gemm g{An, W1 + (size_t)t0 * 256 * 1024, MPAD, 4096, 1024}; pg8::StaticOrder S; S.init(MPAD, 4096, G, cid);
        EpiProj<0> E{PROJ, ssq, cb + (size_t)t0 * 256, nullptr}; pg8::gemm_phase<EpiProj<0>, pg8::StaticOrder>(ldsl, g, S, E, nullptr); }
    else if constexpr (KIND == 12) { const int t0 = layer * 60 + 22; pg8::Gemm g{An, W1 + (size_t)t0 * 256 * 1024, MPAD, 4096, 1024}; pg8::StaticOrder S; S.init(MPAD, 4096, G, cid);
        EpiProj<1> E{PROJ, ssq, cb + (size_t)t0 * 256, (float*)(ws + OFF_LNP)}; pg8::gemm_phase<EpiProj<1>, pg8::StaticOrder>(ldsl, g, S, E, nullptr); }
    else if constexpr (KIND == 7) { prep_phase(p, li, lds); }
    else if constexpr (KIND == 8) { if (G <= 64) { for (int bh = cid; bh < 64; bh += G) scan_block(p, li, bh, lds); for (int it = cid; it < 1024; it += G) sampleA_item(p, li, it >> 3, it & 7, lds); }
        else if (cid < 64) scan_block(p, li, cid, lds);
        else for (int it = cid - 64; it < 1024; it += G - 64) sampleA_item(p, li, it >> 3, it & 7, lds); }
    else if constexpr (KIND == 9) { mixB_phase(p, li, lds); }
    else if constexpr (KIND == 11) { phase_final(p); }
}
__device__ __forceinline__ void run_phase(const Params& p, int ph, unsigned char* lds) {
    int kind, layer, f; decode_phase(ph, kind, layer, f);
    if (kind == 6 && (layer & 1)) kind = 12;
    switch (kind) {
        case 0: run_kind<0>(p, layer, f, lds); break; case 1: run_kind<1>(p, layer, f, lds); break; case 2: run_kind<2>(p, layer, f, lds); break; case 3: run_kind<3>(p, layer, f, lds); break;
        case 4: run_kind<4>(p, layer, f, lds); break; case 5: run_kind<5>(p, layer, f, lds); break; case 6: run_kind<6>(p, layer, f, lds); break; case 7: run_kind<7>(p, layer, f, lds); break;
        case 8: run_kind<8>(p, layer, f, lds); break; case 9: run_kind<9>(p, layer, f, lds); break; case 10: run_kind<10>(p, layer, f, lds); break; case 11: run_kind<11>(p, layer, f, lds); break;
        case 12: run_kind<12>(p, layer, f, lds); break; default: break; }
}
#if MK_MULTI
template <int KIND> __global__ void __launch_bounds__(512, 2) mk_kind(Params p, int layer, int f) {
    extern __shared__ __attribute__((aligned(16))) unsigned char lds[];
    run_kind<KIND>(p, layer, f, lds);
}
#else
__global__ void __launch_bounds__(512, 2) mk_fwd(Params p) {
    extern __shared__ __attribute__((aligned(16))) unsigned char lds[];
    cg::grid_group grid = cg::this_grid();
    for (int ph = p.ph_lo; ph < p.ph_hi; ++ph) {
        run_phase(p, ph, lds);
        if (ph + 1 < p.ph_hi) { __syncthreads(); grid.sync(); }
    }
}
#endif

#if MK_MULTI
template <int KIND> static void launch_kind(const Params& p, int layer, int f, int grid, hipStream_t stream) {
    static bool attr = false;
    if (!attr) { (void)hipFuncSetAttribute((const void*)mk_kind<KIND>, hipFuncAttributeMaxDynamicSharedMemorySize, LDS_BYTES); attr = true; }
    hipLaunchKernelGGL(mk_kind<KIND>, dim3(grid), dim3(512), LDS_BYTES, stream, p, layer, f);
}
#endif
extern "C" void kernel_launch(void* const* d_in, const int* in_sizes, int n_in, void* d_out, int out_size, void* d_ws, size_t ws_size, hipStream_t stream) {
    static int grid = 0;
    if (grid == 0) {
        if (n_in != 24 || ws_size < WS_NEED) { fprintf(stderr, "kernel_launch: n_in %d ws %zu need %zu\n", n_in, ws_size, (size_t)WS_NEED); grid = -1; return; }
        int dev = 0, cus = 0;
        (void)hipGetDevice(&dev); (void)hipDeviceGetAttribute(&cus, hipDeviceAttributeMultiprocessorCount, dev);
#if !MK_MULTI
        int per_cu = 0;
        if (hipFuncSetAttribute((const void*)mk_fwd, hipFuncAttributeMaxDynamicSharedMemorySize, LDS_BYTES) != hipSuccess) { fprintf(stderr, "kernel_launch: hipFuncSetAttribute failed\n"); grid = -1; return; }
        (void)hipOccupancyMaxActiveBlocksPerMultiprocessor(&per_cu, (const void*)mk_fwd, 512, LDS_BYTES);
        (void)hipGetLastError();
        if (per_cu < 1) fprintf(stderr, "kernel_launch: occupancy query says %d\n", per_cu);
#endif
        grid = cus;
    }
    if (grid < 0) return;
    Params p{};
    const float** pp = (const float**)&p;
    for (int i = 0; i < 24; ++i) pp[i] = (const float*)d_in[i];
    p.out = (float*)d_out; p.ws = (unsigned char*)d_ws;
#if MK_MULTI
    for (int ph = 0; ph < NPHASE; ++ph) { int kind, layer, f; decode_phase(ph, kind, layer, f); if (kind == 6 && (layer & 1)) kind = 12;
        switch (kind) {
            case 0: launch_kind<0>(p, layer, f, grid, stream); break; case 1: launch_kind<1>(p, layer, f, grid, stream); break; case 2: launch_kind<2>(p, layer, f, grid, stream); break;
            case 3: launch_kind<3>(p, layer, f, grid, stream); break; case 4: launch_kind<4>(p, layer, f, grid, stream); break; case 5: launch_kind<5>(p, layer, f, grid, stream); break;
            case 6: launch_kind<6>(p, layer, f, grid, stream); break; case 7: launch_kind<7>(p, layer, f, grid, stream); break; case 8: launch_kind<8>(p, layer, f, grid, stream); break;
            case 9: launch_kind<9>(p, layer, f, grid, stream); break; case 10: launch_kind<10>(p, layer, f, grid, stream); break; case 11: launch_kind<11>(p, layer, f, grid, stream); break;
            case 12: launch_kind<12>(p, layer, f, grid, stream); break; default: break; } }
#else
    p.ph_lo = 0; p.ph_hi = NPHASE;
    void* args[] = {&p};
    hipError_t e = hipLaunchCooperativeKernel((const void*)mk_fwd, dim3(grid), dim3(512), args, LDS_BYTES, stream);
    if (e != hipSuccess) fprintf(stderr, "cooperative launch failed: %s (grid %d)\n", hipGetErrorString(e), grid);
#endif
}
```

```cpp
#include <hip/hip_runtime.h>
#include <hip/hip_cooperative_groups.h>
#include <cstdio>
namespace cg = cooperative_groups;
#ifndef MK_MULTI
#define MK_MULTI 0
#endif
#ifndef MK_COOP
#define MK_COOP 1
#endif
namespace pg8 {
#define PG8_LAS __attribute__((address_space(3)))
typedef unsigned short bf16_t;
typedef short bf16x8 __attribute__((ext_vector_type(8)));
typedef float f32x4 __attribute__((ext_vector_type(4)));
typedef unsigned u32x4 __attribute__((ext_vector_type(4)));
constexpr int BM = 256, BK = 64, HALF = 128, HTB = HALF * BK * 2  , STAGE_BYTES = 8 * HTB, NXCD = 8, WGM = 8;

__host__ __device__ __forceinline__ int lds_byte(int r, int c) { const int st = (r >> 4) * 2 + (c >> 5), rr = r & 15, cc = c & 31, ob = rr * 64 + cc * 2; return st * 1024 + (ob ^ (((ob >> 9) & 1) << 5)); }
__host__ __device__ __forceinline__ void stage_rc(int b, int& R, int& C) { const int st = b / 1024, sb = b % 1024, swz = sb ^ (((sb >> 9) & 1) << 5); R = (st >> 1) * 16 + swz / 64; C = (st & 1) * 32 + (swz % 64) / 2; }
__host__ __device__ __forceinline__ int perm32(int rho) { const int n = rho >> 4, i = rho & 15; return 8 * (i >> 2) + 4 * n + (i & 3); }

struct Unit { int pm, pn; };
struct Gemm { const bf16_t* A; const bf16_t* Bt; int M, N, K; };

struct StaticOrder {
    int nM, nN, nwg, G, c;
    __host__ __device__ void init(int M, int N, int G_, int c_) { nM = M / BM; nN = N / BM; nwg = nM * nN; G = G_; c = c_; }
    __host__ __device__ bool next(int i, Unit& u) const {
        const long L = (long)i * G + c; if (L >= nwg) return false;
        int wgid = (int)L; { const int q = nwg / NXCD, r = nwg % NXCD, xcd = wgid % NXCD, off = wgid / NXCD; wgid = (xcd < r ? xcd * (q + 1) : r * (q + 1) + (xcd - r) * q) + off; }
        const int nig = WGM * nN, gid = wgid / nig, fm = gid * WGM, gsz = (nM - fm) < WGM ? (nM - fm) : WGM;
        u.pm = fm + ((wgid % nig) % gsz); u.pn = (wgid % nig) / gsz; return true;
    }
    __device__ __forceinline__ void a_ready(const Unit&) const {}
    __device__ __forceinline__ void done(const Unit&) const {}
};
__device__ __forceinline__ unsigned cvt_pk_bf16(float lo, float hi) { unsigned r; asm volatile("v_cvt_pk_bf16_f32 %0, %1, %2" : "=v"(r) : "v"(lo), "v"(hi)); return r; }
typedef float f32x2 __attribute__((ext_vector_type(2)));
template <class Epi, class Sched, bool STAMP = false>
__device__ __forceinline__ void gemm_phase(PG8_LAS unsigned char* lds, const Gemm g, const Sched& S, const Epi& E, unsigned long long* stamps) {
    int tid_l = threadIdx.x; asm volatile("" : "+v"(tid_l)); const int tid = tid_l, wid = __builtin_amdgcn_readfirstlane(tid >> 6), lane = tid & 63, wr = wid >> 2, wc = wid & 3, fr = lane & 15, fq = lane >> 4;
    const int K = g.K, nt = K / BK;
    int ts_lo = 0, ts_hi = 0, nts = 0; const unsigned long long rt_entry = STAMP ? (unsigned long long)wall_clock64() : 0ull;
#define PG8_STAMP() do { if (STAMP && wid == 0 && nts < 64) { const unsigned long long _c = (unsigned long long)clock64(); \
        ts_lo = (lane == nts) ? (int)(unsigned)_c : ts_lo; ts_hi = (lane == nts) ? (int)(unsigned)(_c >> 32) : ts_hi; ++nts; } } while (0)
    PG8_STAMP();
    unsigned voffA[2], voffB[2];
#pragma unroll
    for (int i = 0; i < 2; ++i) { int R, C; stage_rc(tid * 16 + i * 8192, R, C); const int Rb = Epi::PERM ? ((R & ~31) + perm32(R & 31)) : R;
        voffA[i] = (unsigned)(R * K + C) * 2u; voffB[i] = (unsigned)(Rb * K + C) * 2u; }
    const size_t kstep = (size_t)(BK * 2);
    const size_t hstep = (size_t)HALF * K * 2;
    const size_t tstep = 2 * hstep;
    const unsigned ldsw = (unsigned)wid * 1024u;
    const int aoff = lds_byte(wr * 64 + fr, fq * 8), boff = lds_byte(wc * 32 + fr, fq * 8);
#define PG8_SA(b, h) (((b) * 2 + (h)) * HTB)
#define PG8_SB(b, h) ((4 + (b) * 2 + (h)) * HTB)
#define PG8_STAGE(bufoff, gbase, voff) do { _Pragma("unroll") for (int _i = 0; _i < 2; ++_i) \
        __builtin_amdgcn_global_load_lds((const unsigned*)((const char*)(gbase) + (voff)[_i]), (PG8_LAS unsigned*)(lds + (bufoff) + ldsw + _i * 8192), 16, 0, 0); } while (0)
#define PG8_LDA(dst, b, h) do { _Pragma("unroll") for (int m = 0; m < 4; ++m) _Pragma("unroll") for (int k = 0; k < 2; ++k) dst[m][k] = *(const PG8_LAS bf16x8*)(lds + PG8_SA(b, h) + aoff + m * 2048 + k * 1024); } while (0)
#define PG8_LDB(dst, b, h) do { _Pragma("unroll") for (int n = 0; n < 2; ++n) _Pragma("unroll") for (int k = 0; k < 2; ++k) dst[n][k] = *(const PG8_LAS bf16x8*)(lds + PG8_SB(b, h) + boff + n * 2048 + k * 1024); } while (0)
#define PG8_MMA(ai, bj, At, Bt) do { __builtin_amdgcn_s_setprio(1); _Pragma("unroll") for (int m = 0; m < 4; ++m) _Pragma("unroll") for (int n = 0; n < 2; ++n) _Pragma("unroll") for (int k = 0; k < 2; ++k) \
        acc[ai][bj][m][n] = __builtin_amdgcn_mfma_f32_16x16x32_bf16(Bt[n][k], At[m][k], acc[ai][bj][m][n], 0, 0, 0); __builtin_amdgcn_s_setprio(0); } while (0)
#define PG8_WAIT_V(n) asm volatile("s_waitcnt vmcnt(" #n ")" ::: "memory")
#define PG8_WAIT_L(n) asm volatile("s_waitcnt lgkmcnt(" #n ")" ::: "memory")
#define PG8_BAR __builtin_amdgcn_s_barrier()
#define PG8_SCHED __builtin_amdgcn_sched_barrier(0)
    Unit cur, nxt; int ui = 0;
    if (!S.next(0, cur)) return;
    f32x4 acc[2][2][4][2];
#pragma unroll
    for (int a = 0; a < 2; ++a)
#pragma unroll
        for (int b = 0; b < 2; ++b)
#pragma unroll
            for (int m = 0; m < 4; ++m)
#pragma unroll
                for (int n = 0; n < 2; ++n) acc[a][b][m][n] = (f32x4){0.f, 0.f, 0.f, 0.f};
    bf16x8 At[4][2], B0[2][2], B1[2][2];
    const char* cA = (const char*)g.A + (size_t)cur.pm * tstep; const char* cB = (const char*)g.Bt + (size_t)cur.pn * tstep;
    S.a_ready(cur);
    PG8_STAGE(PG8_SB(0, 0), cB, voffB); PG8_STAGE(PG8_SA(0, 0), cA, voffA); PG8_STAGE(PG8_SB(0, 1), cB + hstep, voffB); PG8_STAGE(PG8_SA(0, 1), cA + hstep, voffA);
    if (wr == 1) PG8_BAR;
    PG8_WAIT_V(4); PG8_BAR;
    PG8_STAGE(PG8_SB(1, 0), cB + kstep, voffB); PG8_STAGE(PG8_SA(1, 0), cA + kstep, voffA); PG8_STAGE(PG8_SB(1, 1), cB + hstep + kstep, voffB);
    PG8_WAIT_V(6); PG8_BAR;
    PG8_STAMP();
    for (;;) {
        const bool has_next = S.next(ui + 1, nxt);
        const char* nA = has_next ? (const char*)g.A + (size_t)nxt.pm * tstep : cA; const char* nB = has_next ? (const char*)g.Bt + (size_t)nxt.pn * tstep : cB;
        for (int t = 0; t < nt; t += 2) {
            const bool last = (t == nt - 2);
            const char* a1 = cA + (size_t)(t + 1) * kstep;
            const char* a2 = last ? nA : cA + (size_t)(t + 2) * kstep; const char* b2 = last ? nB : cB + (size_t)(t + 2) * kstep;
            const char* a3 = a2 + kstep; const char* b3 = b2 + kstep;
            if (last && has_next) S.a_ready(nxt);
            PG8_LDB(B0, 0, 0); PG8_SCHED; PG8_LDA(At, 0, 0); PG8_STAGE(PG8_SA(1, 1), a1 + hstep, voffA);
            PG8_WAIT_L(8); PG8_BAR; PG8_WAIT_L(0); PG8_MMA(0, 0, At, B0); PG8_BAR; PG8_SCHED;
            PG8_LDB(B1, 0, 1); PG8_STAGE(PG8_SB(0, 0), b2, voffB);
            PG8_BAR; PG8_WAIT_L(0); PG8_MMA(0, 1, At, B1); PG8_BAR;
            PG8_LDA(At, 0, 1); PG8_STAGE(PG8_SA(0, 0), a2, voffA);
            PG8_BAR; PG8_WAIT_L(0); PG8_MMA(1, 0, At, B0); PG8_BAR; PG8_SCHED;
            PG8_STAGE(PG8_SB(0, 1), b2 + hstep, voffB);
            PG8_WAIT_V(6); PG8_BAR; PG8_MMA(1, 1, At, B1); PG8_BAR;
            PG8_LDB(B0, 1, 0); PG8_SCHED; PG8_LDA(At, 1, 0); PG8_STAGE(PG8_SA(0, 1), a2 + hstep, voffA);
            PG8_WAIT_L(8); PG8_BAR; PG8_WAIT_L(0); PG8_MMA(0, 0, At, B0); PG8_BAR; PG8_SCHED;
            PG8_LDB(B1, 1, 1); PG8_STAGE(PG8_SB(1, 0), b3, voffB);
            PG8_BAR; PG8_WAIT_L(0); PG8_MMA(0, 1, At, B1); PG8_BAR;
            PG8_LDA(At, 1, 1); PG8_STAGE(PG8_SA(1, 0), a3, voffA);
            PG8_BAR; PG8_WAIT_L(0); PG8_MMA(1, 0, At, B0); PG8_BAR; PG8_SCHED;
            PG8_STAGE(PG8_SB(1, 1), b3 + hstep, voffB);
            PG8_WAIT_V(6); PG8_BAR; PG8_MMA(1, 1, At, B1); PG8_BAR;
        }
        PG8_STAMP();
        if constexpr (!Epi::AFTER_DRAIN) { E(acc, cur, wr, wc, fr, fq); S.done(cur); }
        PG8_STAMP();
        if (!has_next) break;
#pragma unroll
        for (int a = 0; a < 2; ++a)
#pragma unroll
            for (int b = 0; b < 2; ++b)
#pragma unroll
                for (int m = 0; m < 4; ++m)
#pragma unroll
                    for (int n = 0; n < 2; ++n) acc[a][b][m][n] = (f32x4){0.f, 0.f, 0.f, 0.f};
        cur = nxt; cA = nA; cB = nB; ++ui;
    }
    PG8_WAIT_V(0);
    if (wr == 0) PG8_BAR;
    PG8_BAR;
    if constexpr (Epi::AFTER_DRAIN) { E.fused(acc, cur, wr, wc, fr, fq, lds, wid, lane); S.done(cur); }
    PG8_STAMP();
    if (STAMP && wid == 0) { stamps[lane] = lane < nts ? (((unsigned long long)(unsigned)ts_hi << 32) | (unsigned)ts_lo) : 0ull;
        if (lane == 62) stamps[62] = rt_entry; if (lane == 63) stamps[63] = (unsigned long long)wall_clock64(); }
#undef PG8_STAMP
#undef PG8_SA
#undef PG8_SB
#undef PG8_STAGE
#undef PG8_LDA
#undef PG8_LDB
#undef PG8_MMA
#undef PG8_WAIT_V
#undef PG8_WAIT_L
#undef PG8_BAR
#undef PG8_SCHED
}
}
#define XB_TMO      128
#define XB_XCNT(j)  (256  + 64 * (j))
#define XB_XSUB(j)  (1280 + 64 * (j))
#define XB_XGEN(j)  (2304 + 64 * (j))
#define XB_TOP      3328
#define XB_TOPGEN   3392
#define XCD_BAR_WORDS 3456
#define XB_SPIN_CAP (1u << 18)
#define LAS __attribute__((address_space(3)))

__device__ __forceinline__ unsigned xb_ld(unsigned* p)              { return __hip_atomic_load(p, __ATOMIC_RELAXED, __HIP_MEMORY_SCOPE_AGENT); }
__device__ __forceinline__ unsigned xb_add(unsigned* p, unsigned v) { return __hip_atomic_fetch_add(p, v, __ATOMIC_RELAXED, __HIP_MEMORY_SCOPE_AGENT); }
__device__ __forceinline__ unsigned xb_xcc_id() { return (unsigned)__builtin_amdgcn_s_getreg((3 << 11) | 20) & 0xFu; }
#define XB_SPIN(cond, bar) do { unsigned _sp = 0; while (cond) { __builtin_amdgcn_s_sleep(1); \
    if ((++_sp & 255u) == 0u) { if (xb_ld(&(bar)[XB_TMO])) break; if (_sp > XB_SPIN_CAP) { atomicAdd(&(bar)[XB_TMO], 1u); break; } } } } while (0)

struct XcdBarrier {
    unsigned* bar; unsigned x;
    volatile LAS unsigned* st;
};

__device__ __forceinline__ XcdBarrier xcd_barrier_post(unsigned* bar, volatile LAS unsigned* st) {
    XcdBarrier b; b.bar = bar; b.x = xb_xcc_id(); b.st = st;
    if (threadIdx.x == 0) (void)xb_add(&bar[XB_XCNT(b.x)], 1u);
    return b;
}
__device__ __forceinline__ void xcd_barrier_complete(unsigned* bar, unsigned x, unsigned& nloc, unsigned& nx) {
    const unsigned G = gridDim.x * gridDim.y * gridDim.z;
    unsigned sum, cnt, mine, sp = 0u;
    for (;;) {
        sum = 0u; cnt = 0u; mine = 0u;
#pragma unroll
        for (unsigned j = 0; j < 16; ++j) { const unsigned c = xb_ld(&bar[XB_XCNT(j)]); sum += c; cnt += (c > 0u) ? 1u : 0u; mine = (j == x) ? c : mine; }
        if (sum == G) break;
        __builtin_amdgcn_s_sleep(1);
        if ((++sp & 255u) == 0u) { if (xb_ld(&bar[XB_TMO])) break; if (sp > XB_SPIN_CAP) { atomicAdd(&bar[XB_TMO], 1u); break; } }
    }
    nloc = mine > 0u ? mine : 1u; nx = cnt > 0u ? cnt : 1u;
}

__device__ __forceinline__ void xcd_barrier(const XcdBarrier& b) {
    asm volatile("s_waitcnt vmcnt(0)" ::: "memory");
    __syncthreads();
    if (threadIdx.x == 0) {
        unsigned* bar = b.bar;
        __builtin_amdgcn_s_waitcnt(0);
        unsigned nloc = b.st[0], nx = b.st[1];
        if (nloc == 0u) { xcd_barrier_complete(bar, b.x, nloc, nx); b.st[0] = nloc; b.st[1] = nx; }
        const unsigned old = xb_add(&bar[XB_XSUB(b.x)], 1u);
        const unsigned gen = old / nloc;
        if (old + 1u == (gen + 1u) * nloc) {
            __builtin_amdgcn_fence(__ATOMIC_RELEASE, "agent");
            asm volatile("s_waitcnt vmcnt(0)" ::: "memory");
            const unsigned og = xb_add(&bar[XB_TOP], 1u);
            const unsigned tg = og / nx;
            if (og + 1u == (tg + 1u) * nx) xb_add(&bar[XB_TOPGEN], 1u);
            else XB_SPIN(xb_ld(&bar[XB_TOPGEN]) == tg, bar);
            __builtin_amdgcn_fence(__ATOMIC_ACQUIRE, "agent");
            xb_add(&bar[XB_XGEN(b.x)], 1u);
            asm volatile("s_waitcnt vmcnt(0)" ::: "memory");
        } else {
            XB_SPIN(xb_ld(&bar[XB_XGEN(b.x)]) == gen, bar);
            __builtin_amdgcn_fence(__ATOMIC_ACQUIRE, "agent");
            asm volatile("s_waitcnt vmcnt(0)" ::: "memory");
        }
    }
    __syncthreads();
}

using pg8::bf16_t; using pg8::bf16x8; using pg8::f32x4; using pg8::Unit; using pg8::cvt_pk_bf16;
typedef unsigned u32x2 __attribute__((ext_vector_type(2)));
typedef unsigned u32x4 __attribute__((ext_vector_type(4)));
constexpr int MPAD = 16640, MODLD = 36864, CBLD = 61440, LDS_BYTES = 143360, NPHASE = 35;
constexpr size_t ITEM_BYTES = 73792;
constexpr size_t OFF_W1 = 0, SZ_W1 = (size_t)4 * 60 * 256 * 1024 * 2;
constexpr size_t OFF_WDN = OFF_W1 + SZ_W1, SZ_WDN = (size_t)8 * 1024 * 2816 * 2;
constexpr size_t OFF_WOA = OFF_WDN + SZ_WDN, SZ_WOA = (size_t)2 * 1024 * 1024 * 2;
constexpr size_t OFF_WOB = OFF_WOA + SZ_WOA, SZ_WOB = (size_t)2 * 1024 * 2048 * 2;
constexpr size_t OFF_MOD = OFF_WOB + SZ_WOB, SZ_MOD = (size_t)136 * MODLD * 4;
constexpr size_t OFF_CB = OFF_MOD + SZ_MOD, SZ_CB = (size_t)136 * CBLD * 4;
constexpr size_t OFF_SH = OFF_CB + SZ_CB, SZ_SH = (size_t)12 * 256 * 1024 * 2;
constexpr size_t OFF_SC = OFF_SH + SZ_SH, SZ_SC = (size_t)256 * 1024 * 2;
constexpr size_t OFF_WLOG = OFF_SC + SZ_SC, SZ_WLOG = (size_t)2 * 16 * 1024 * 4;
constexpr size_t OFF_CB16 = OFF_WLOG + SZ_WLOG, SZ_CB16 = (size_t)2 * 136 * 16 * 4 + 16384 + 16384 + 65536;
constexpr size_t OFF_BAR = OFF_CB16 + (size_t)2 * 136 * 16 * 4;
constexpr size_t OFF_SSQS = OFF_BAR + 16384;
constexpr size_t OFF_LNPS = OFF_SSQS + 16384;
constexpr size_t OFF_X = OFF_CB16 + SZ_CB16, SZ_X = (size_t)MPAD * 1024 * 4;
constexpr size_t OFF_AN = OFF_X + SZ_X, SZ_AN = (size_t)MPAD * 1024 * 2;
constexpr size_t OFF_SSQ = OFF_AN + SZ_AN, SZ_SSQ = (size_t)MPAD * 16 * 4;
constexpr size_t OFF_LNP = OFF_SSQ + SZ_SSQ, SZ_LNP = (size_t)MPAD * 64 * 4;
constexpr size_t OFF_PROJ = OFF_LNP + SZ_LNP, SZ_PROJ = (size_t)MPAD * 4096 * 2;
constexpr size_t OFF_OAB = OFF_PROJ + SZ_PROJ, SZ_OAB = (size_t)MPAD * 2048 * 2;
constexpr size_t OFF_R1 = OFF_OAB + SZ_OAB, SZ_R1 = (size_t)2048 * ITEM_BYTES;
constexpr size_t WS_NEED = OFF_R1 + SZ_R1;
static_assert(SZ_R1 >= (size_t)MPAD * 2816 * 2 && SZ_R1 >= (size_t)36864 * 1024 * 2, "R1");
static_assert(OFF_X % 256 == 0 && OFF_R1 % 256 == 0 && OFF_PROJ % 256 == 0, "align");
constexpr size_t OUT_Y = 0, OUT_CONVP = (size_t)16512 * 1024, OUT_SP = OUT_CONVP + 2 * 8 * 3 * 3072, OUT_CONVS = OUT_SP + (size_t)2 * 8 * 8 * 128 * 128,
                 OUT_SS = OUT_CONVS + (size_t)2 * 128 * 3 * 3072, OUT_VS = OUT_SS + (size_t)2 * 128 * 8 * 128 * 128;

struct Params {
    const float *x_prompt, *x_sample, *st_conv, *st_S, *c_prompt, *c_sample, *w_ada, *b_ada, *norm_w, *w_gu, *w_down, *a_w_in, *a_w_conv, *a_log, *a_dt_bias,
        *a_w_onorm, *a_w_out, *b_w_in, *b_vnorm_w, *b_vnorm_b, *b_w_s, *b_b_s, *b_w_out, *final_w;
    float* out; unsigned char* ws; int ph_lo, ph_hi;
};

__device__ __forceinline__ int tidx() { int t = threadIdx.x; asm volatile("" : "+v"(t)); return t; }
__device__ __forceinline__ float bf2f(bf16_t b) { return __uint_as_float(((unsigned)b) << 16); }
__device__ __forceinline__ bf16_t f2bf(float f) { return (bf16_t)(cvt_pk_bf16(f, 0.f) & 0xffffu); }
__device__ __forceinline__ float wsum(float v) {
#pragma unroll
    for (int o = 32; o >= 1; o >>= 1) v += __shfl_xor(v, o);
    return v; }
__device__ __forceinline__ void lds_barrier() { asm volatile("s_waitcnt lgkmcnt(0)\n\ts_barrier" ::: "memory"); }
template <int CTRL> __device__ __forceinline__ float dppf(float v) { return __builtin_bit_cast(float, __builtin_amdgcn_update_dpp(0, __builtin_bit_cast(int, v), CTRL, 0xF, 0xF, false)); }
__device__ __forceinline__ float row16_sum(float v) {
    v += dppf<0xB1>(v); v += dppf<0x4E>(v); v += dppf<0x141>(v); v += dppf<0x140>(v); return v; }
__device__ __forceinline__ float sigmoidf_(float x) { return __builtin_amdgcn_rcpf(1.0f + __expf(-x)); }
__device__ __forceinline__ float siluf_(float x) { return x * sigmoidf_(x); }
__device__ __forceinline__ float gelu_tanh(float x) { const float u2 = 1.5957691216f * (x + 0.044715f * x * x * x); return x * sigmoidf_(u2); }
__device__ __forceinline__ int row_b(int row) { return row < 16384 ? (row >> 11) : min(row - 16384 + 8, 135); }
__device__ __forceinline__ float row_rstd(const float* ssq, int row) {
    const f32x4* q = (const f32x4*)(ssq + (size_t)row * 16); const f32x4 a = q[0], b = q[1], c = q[2], d = q[3];
    const float s = ((a[0] + a[1]) + (a[2] + a[3])) + ((b[0] + b[1]) + (b[2] + b[3])) + ((c[0] + c[1]) + (c[2] + c[3])) + ((d[0] + d[1]) + (d[2] + d[3]));
    return rsqrtf(s * (1.0f / 1024.0f) + 1e-6f); }
__device__ __forceinline__ float srow_rstd(const float* ssqS, int r) { const f32x4* q = (const f32x4*)(ssqS + r * 32); float s = 0.f;
#pragma unroll
    for (int j = 0; j < 8; ++j) { const f32x4 a = q[j]; s += (a[0] + a[1]) + (a[2] + a[3]); }
    return rsqrtf(s * (1.0f / 1024.0f) + 1e-6f); }
__device__ __forceinline__ float row_rstd4(const float* ssq, int row, int fq) {
    const f32x4 a = *(const f32x4*)(ssq + (size_t)row * 16 + 4 * fq); float s = (a[0] + a[1]) + (a[2] + a[3]); s += __shfl_xor(s, 16); s += __shfl_xor(s, 32);
    return rsqrtf(s * (1.0f / 1024.0f) + 1e-6f); }
__device__ __forceinline__ u32x2 pack4(f32x4 v) { u32x2 r; r.x = cvt_pk_bf16(v[0], v[1]); r.y = cvt_pk_bf16(v[2], v[3]); return r; }
__device__ __forceinline__ bf16x8 pack8(f32x4 a, f32x4 b) { u32x4 r; r.x = cvt_pk_bf16(a[0], a[1]); r.y = cvt_pk_bf16(a[2], a[3]); r.z = cvt_pk_bf16(b[0], b[1]); r.w = cvt_pk_bf16(b[2], b[3]);
    return __builtin_bit_cast(bf16x8, r); }
__device__ __forceinline__ f32x4 unpack4(u32x2 w) { f32x4 r; r[0] = __uint_as_float(w.x << 16); r[1] = __uint_as_float(w.x & 0xffff0000u); r[2] = __uint_as_float(w.y << 16); r[3] = __uint_as_float(w.y & 0xffff0000u); return r; }

struct EpiMod {
    static constexpr bool PERM = false, AFTER_DRAIN = false;
    float* C; const float* bias;
    __device__ __forceinline__ void operator()(const f32x4 (&acc)[2][2][4][2], const Unit& u, int wr, int wc, int fr, int fq) const {
#pragma unroll
        for (int ai = 0; ai < 2; ++ai)
#pragma unroll
            for (int m = 0; m < 4; ++m) { const int r = ai * 128 + wr * 64 + m * 16 + fr; if (r < 136) {
#pragma unroll
                for (int bj = 0; bj < 2; ++bj)
#pragma unroll
                    for (int n = 0; n < 2; ++n) { const int c = u.pn * 256 + bj * 128 + wc * 32 + n * 16 + 4 * fq;
                        *(f32x4*)(C + (size_t)r * MODLD + c) = acc[ai][bj][m][n] + *(const f32x4*)(bias + c); } } }
    }
};
struct EpiCb {
    static constexpr bool PERM = false, AFTER_DRAIN = false;
    float* C;
    __device__ __forceinline__ void operator()(const f32x4 (&acc)[2][2][4][2], const Unit& u, int wr, int wc, int fr, int fq) const {
#pragma unroll
        for (int ai = 0; ai < 2; ++ai)
#pragma unroll
            for (int m = 0; m < 4; ++m) { const int r = ai * 128 + wr * 64 + m * 16 + fr; if (r < 136) {
#pragma unroll
                for (int bj = 0; bj < 2; ++bj)
#pragma unroll
                    for (int n = 0; n < 2; ++n) { const int c = u.pn * 256 + bj * 128 + wc * 32 + n * 16 + 4 * fq;
                        *(f32x4*)(C + (size_t)r * CBLD + c) = acc[ai][bj][m][n]; } } }
    }
};
struct CbOrder {
    int G, c;
    __device__ bool next(int i, Unit& u) const { const int L = i * G + c; if (L >= 240) return false; const int layer = L / 60, rem = L % 60; u.pm = layer * 3 + (rem < 22 ? 0 : (rem < 38 ? 1 : 2)); u.pn = L; return true; }
    __device__ __forceinline__ void a_ready(const Unit&) const {}
    __device__ __forceinline__ void done(const Unit&) const {}
};
struct EpiDummy {
    static constexpr bool PERM = true, AFTER_DRAIN = false;
    bf16_t* O;
    __device__ __forceinline__ void operator()(const f32x4 (&acc)[2][2][4][2], const Unit& u, int wr, int wc, int fr, int fq) const {
#pragma unroll
        for (int ai = 0; ai < 2; ++ai)
#pragma unroll
            for (int m = 0; m < 4; ++m) { const int row = u.pm * 256 + ai * 128 + wr * 64 + m * 16 + fr;
#pragma unroll
                for (int bj = 0; bj < 2; ++bj) { u32x4 w; w.x = cvt_pk_bf16(acc[ai][bj][m][0][0], acc[ai][bj][m][0][1]); w.y = cvt_pk_bf16(acc[ai][bj][m][0][2], acc[ai][bj][m][0][3]); w.z = cvt_pk_bf16(acc[ai][bj][m][1][0], acc[ai][bj][m][1][1]); w.w = cvt_pk_bf16(acc[ai][bj][m][1][2], acc[ai][bj][m][1][3]);
                    *(u32x4*)(O + (size_t)row * 4096 + (u.pn % 16) * 256 + bj * 128 + wc * 32 + 8 * fq) = w; } }
    }
};
struct EpiSwiglu {
    static constexpr bool PERM = true, AFTER_DRAIN = false;
    bf16_t* O; const float* ssq; const float* cb;
    __device__ __forceinline__ void operator()(const f32x4 (&acc)[2][2][4][2], const Unit& u, int wr, int wc, int fr, int fq) const {
        const int cl = wc * 32 + 8 * fq; float rs[2][4];
#pragma unroll
        for (int ai = 0; ai < 2; ++ai)
#pragma unroll
            for (int m = 0; m < 4; ++m) rs[ai][m] = row_rstd4(ssq, u.pm * 256 + ai * 128 + wr * 64 + m * 16 + fr, fq);
        if (u.pm < 64) {
            const float* cbr = cb + (size_t)(u.pm >> 3) * CBLD + u.pn * 256 + cl;
            const f32x4 cg0 = *(const f32x4*)(cbr), cg1 = *(const f32x4*)(cbr + 4), cu0 = *(const f32x4*)(cbr + 128), cu1 = *(const f32x4*)(cbr + 132);
#pragma unroll
            for (int ai = 0; ai < 2; ++ai)
#pragma unroll
                for (int m = 0; m < 4; ++m) { const int row = u.pm * 256 + ai * 128 + wr * 64 + m * 16 + fr; const float r_ = rs[ai][m];
                    const f32x4 g0 = acc[ai][0][m][0] * r_ + cg0, g1 = acc[ai][0][m][1] * r_ + cg1, u0 = acc[ai][1][m][0] * r_ + cu0, u1 = acc[ai][1][m][1] * r_ + cu1; f32x4 h0, h1;
#pragma unroll
                    for (int j = 0; j < 4; ++j) { h0[j] = siluf_(g0[j]) * u0[j]; h1[j] = siluf_(g1[j]) * u1[j]; }
                    u32x4 w; w.x = cvt_pk_bf16(h0[0], h0[1]); w.y = cvt_pk_bf16(h0[2], h0[3]); w.z = cvt_pk_bf16(h1[0], h1[1]); w.w = cvt_pk_bf16(h1[2], h1[3]);
                    *(u32x4*)(O + (size_t)row * 2816 + u.pn * 128 + cl) = w; }
        } else {
#pragma unroll
            for (int ai = 0; ai < 2; ++ai)
#pragma unroll
                for (int m = 0; m < 4; ++m) { const int row = u.pm * 256 + ai * 128 + wr * 64 + m * 16 + fr; const int b = row_b(row); const float r_ = rs[ai][m];
                    const float* cbr = cb + (size_t)b * CBLD + u.pn * 256 + cl;
                    const f32x4 g0 = acc[ai][0][m][0] * r_ + *(const f32x4*)(cbr), g1 = acc[ai][0][m][1] * r_ + *(const f32x4*)(cbr + 4);
                    const f32x4 u0 = acc[ai][1][m][0] * r_ + *(const f32x4*)(cbr + 128), u1 = acc[ai][1][m][1] * r_ + *(const f32x4*)(cbr + 132); f32x4 h0, h1;
#pragma unroll
                    for (int j = 0; j < 4; ++j) { h0[j] = siluf_(g0[j]) * u0[j]; h1[j] = siluf_(g1[j]) * u1[j]; }
                    u32x4 w; w.x = cvt_pk_bf16(h0[0], h0[1]); w.y = cvt_pk_bf16(h0[2], h0[3]); w.z = cvt_pk_bf16(h1[0], h1[1]); w.w = cvt_pk_bf16(h1[2], h1[3]);
                    *(u32x4*)(O + (size_t)row * 2816 + u.pn * 128 + cl) = w; }
        }
    }
};
struct EpiResid {
    static constexpr bool PERM = true, AFTER_DRAIN = false;
    bf16_t* An; float* ssq; const float* mod; const float* nw; const float* pw; int goff, soff, poff; float coef;
    __device__ __forceinline__ void operator()(const f32x4 (&acc)[2][2][4][2], const Unit& u, int wr, int wc, int fr, int fq) const {
        const float* modr = mod + (size_t)(u.pm >> 3) * MODLD; float ss[2][4];
#pragma unroll
        for (int ai = 0; ai < 2; ++ai)
#pragma unroll
            for (int m = 0; m < 4; ++m) ss[ai][m] = 0.f;
#pragma unroll
        for (int bj = 0; bj < 2; ++bj) { const int c = u.pn * 256 + bj * 128 + wc * 32 + 8 * fq; f32x4 g[2], a[2], ia[2];
#pragma unroll
            for (int n = 0; n < 2; ++n) { g[n] = (*(const f32x4*)(modr + goff + c + 4 * n) + 1.0f) * coef; a[n] = (f32x4){1.f, 1.f, 1.f, 1.f};
                if (nw) a[n] = *(const f32x4*)(nw + c + 4 * n) * (*(const f32x4*)(modr + soff + c + 4 * n) + 1.0f);
                const f32x4 ap = *(const f32x4*)(pw + c + 4 * n) * (*(const f32x4*)(modr + poff + c + 4 * n) + 1.0f);
                ia[n][0] = __builtin_amdgcn_rcpf(ap[0]); ia[n][1] = __builtin_amdgcn_rcpf(ap[1]); ia[n][2] = __builtin_amdgcn_rcpf(ap[2]); ia[n][3] = __builtin_amdgcn_rcpf(ap[3]); }
#pragma unroll
            for (int am = 0; am < 4; ++am) { const int ai = am >> 1; u32x4 xr[2];
#pragma unroll
                for (int mm = 0; mm < 2; ++mm) xr[mm] = *(const u32x4*)(An + (size_t)(u.pm * 256 + ai * 128 + wr * 64 + ((am & 1) * 2 + mm) * 16 + fr) * 1024 + c);
#pragma unroll
                for (int mm = 0; mm < 2; ++mm) { const int m = (am & 1) * 2 + mm; const size_t row = (size_t)(u.pm * 256 + ai * 128 + wr * 64 + m * 16 + fr);
                    const f32x4 x0 = unpack4((u32x2){xr[mm].x, xr[mm].y}) * ia[0] + g[0] * acc[ai][bj][m][0], x1 = unpack4((u32x2){xr[mm].z, xr[mm].w}) * ia[1] + g[1] * acc[ai][bj][m][1];
                    ss[ai][m] += ((x0[0] * x0[0] + x0[1] * x0[1]) + (x0[2] * x0[2] + x0[3] * x0[3])) + ((x1[0] * x1[0] + x1[1] * x1[1]) + (x1[2] * x1[2] + x1[3] * x1[3]));
                    const u32x2 pa = pack4(x0 * a[0]), pb = pack4(x1 * a[1]); *(u32x4*)(An + row * 1024 + c) = (u32x4){pa.x, pa.y, pb.x, pb.y}; } } }
#pragma unroll
        for (int ai = 0; ai < 2; ++ai)
#pragma unroll
            for (int m = 0; m < 4; ++m) { float s = ss[ai][m]; s += __shfl_xor(s, 16); s += __shfl_xor(s, 32);
                if (fq == 0) ssq[(size_t)(u.pm * 256 + ai * 128 + wr * 64 + m * 16 + fr) * 16 + u.pn * 4 + wc] = s; }
    }
};
template <int ACT> struct EpiProj {
    static constexpr bool PERM = true, AFTER_DRAIN = false;
    bf16_t* O; const float* ssq; const float* cb; float* lnp;
    __device__ __forceinline__ void operator()(const f32x4 (&acc)[2][2][4][2], const Unit& u, int wr, int wc, int fr, int fq) const {
        float rsv[2][4];
#pragma unroll
        for (int ai = 0; ai < 2; ++ai)
#pragma unroll
            for (int m = 0; m < 4; ++m) rsv[ai][m] = row_rstd4(ssq, u.pm * 256 + ai * 128 + wr * 64 + m * 16 + fr, fq);
        f32x4 cbv[2][2];
        if (u.pm < 64) {
#pragma unroll
            for (int bj = 0; bj < 2; ++bj) { const float* cbr = cb + (size_t)(u.pm >> 3) * CBLD + u.pn * 256 + bj * 128 + wc * 32 + 8 * fq; cbv[bj][0] = *(const f32x4*)cbr; cbv[bj][1] = *(const f32x4*)(cbr + 4); } }
#pragma unroll
        for (int ai = 0; ai < 2; ++ai)
#pragma unroll
            for (int m = 0; m < 4; ++m) { const int row = u.pm * 256 + ai * 128 + wr * 64 + m * 16 + fr; const int b = row_b(row); const float rs = rsv[ai][m]; float s1 = 0.f, s2 = 0.f;
#pragma unroll
                for (int bj = 0; bj < 2; ++bj) { const int c0 = u.pn * 256 + bj * 128 + wc * 32 + 8 * fq; const float* cbr = cb + (size_t)b * CBLD + c0;
                    f32x4 c0v = cbv[bj][0], c1v = cbv[bj][1]; if (u.pm >= 64) { c0v = *(const f32x4*)(cbr); c1v = *(const f32x4*)(cbr + 4); }
                    f32x4 v0 = acc[ai][bj][m][0] * rs + c0v, v1 = acc[ai][bj][m][1] * rs + c1v;
                    if (ACT) {
#pragma unroll
                        for (int j = 0; j < 4; ++j) { v0[j] = gelu_tanh(v0[j]); v1[j] = gelu_tanh(v1[j]); }
                        s1 += ((v0[0] + v0[1]) + (v0[2] + v0[3])) + ((v1[0] + v1[1]) + (v1[2] + v1[3]));
                        s2 += ((v0[0] * v0[0] + v0[1] * v0[1]) + (v0[2] * v0[2] + v0[3] * v0[3])) + ((v1[0] * v1[0] + v1[1] * v1[1]) + (v1[2] * v1[2] + v1[3] * v1[3])); }
                    u32x4 w; w.x = cvt_pk_bf16(v0[0], v0[1]); w.y = cvt_pk_bf16(v0[2], v0[3]); w.z = cvt_pk_bf16(v1[0], v1[1]); w.w = cvt_pk_bf16(v1[2], v1[3]);
                    *(u32x4*)(O + (size_t)row * 4096 + c0) = w; }
                if (ACT) { s1 += __shfl_xor(s1, 16); s1 += __shfl_xor(s1, 32); s2 += __shfl_xor(s2, 16); s2 += __shfl_xor(s2, 32);
                    if (u.pn >= 8 && fq == 0) { float* q = lnp + ((size_t)row * 32 + (u.pn - 8) * 4 + wc) * 2; q[0] = s1; q[1] = s2; } } }
    }
};

struct SkArgs { const bf16_t* A; const bf16_t* Bt; int K, N; const float* cb; bf16_t* O; bf16_t* An; const float* mod; const float* nw; const float* pw; int goff, soff, poff; float coef; };
template <int MODE, int RT> __device__ __forceinline__ void skinny_phase(const Params& p, const SkArgs& a, int owner_kind, unsigned char* lds) {
    constexpr int NB = (RT == 2) ? 11 : 2, NRG = 8 / RT, RR = 16 * RT;
    const int tid = tidx(), lane = tid & 63, wv = __builtin_amdgcn_readfirstlane(tid >> 6), fr = lane & 15, fq = lane >> 4; const int G = gridDim.x, cid = blockIdx.x;
    float* ssqS = (float*)(p.ws + OFF_SSQS); float* lnpS = (float*)(p.ws + OFF_LNPS); float* red = (float*)lds;
    const int ncc = a.N >> 5, nch = ncc * NRG, K = a.K, ksl = K >> 3, nks = ksl >> 5, kb = wv * ksl;
    for (int jx = 0; jx < nch; ++jx) {
        int own; if (owner_kind == 0) own = (G >= 256) ? 128 + (jx & 127) : jx % G; else own = (2 * jx + ((jx >> 2) & 1)) % G;
        if (own != cid) continue;
        const int j = jx / NRG, rg = jx % NRG;
        int n0, n1; if (MODE == 0) { n0 = (j >> 3) * 256 + (j & 7) * 16; n1 = n0 + 128; } else { n0 = j * 32; n1 = n0 + 16; }
        f32x4 acc[RT][2];
#pragma unroll
        for (int m = 0; m < RT; ++m) { acc[m][0] = (f32x4){0.f, 0.f, 0.f, 0.f}; acc[m][1] = (f32x4){0.f, 0.f, 0.f, 0.f}; }
        const bf16_t* Ab = a.A + (size_t)(rg * RR + fr) * K + kb + 8 * fq; const bf16_t* B0 = a.Bt + (size_t)(n0 + fr) * K + kb + 8 * fq; const bf16_t* B1 = a.Bt + (size_t)(n1 + fr) * K + kb + 8 * fq;
#pragma unroll 1
        for (int ks0 = 0; ks0 < nks; ks0 += NB) { const int nb = min(NB, nks - ks0); bf16x8 af[NB][RT], bfr[NB][2];
#pragma unroll
            for (int s = 0; s < NB; ++s) if (s < nb) {
#pragma unroll
                for (int m = 0; m < RT; ++m) af[s][m] = *(const bf16x8*)(Ab + (size_t)m * 16 * K + (ks0 + s) * 32);
                bfr[s][0] = *(const bf16x8*)(B0 + (ks0 + s) * 32); bfr[s][1] = *(const bf16x8*)(B1 + (ks0 + s) * 32); }
#pragma unroll
            for (int s = 0; s < NB; ++s) if (s < nb) {
#pragma unroll
                for (int m = 0; m < RT; ++m) { acc[m][0] = __builtin_amdgcn_mfma_f32_16x16x32_bf16(bfr[s][0], af[s][m], acc[m][0], 0, 0, 0); acc[m][1] = __builtin_amdgcn_mfma_f32_16x16x32_bf16(bfr[s][1], af[s][m], acc[m][1], 0, 0, 0); } } }
#pragma unroll
        for (int m = 0; m < RT; ++m) { *(f32x4*)(red + (size_t)(wv * RR + 16 * m + fr) * 32 + 4 * fq) = acc[m][0]; *(f32x4*)(red + (size_t)(wv * RR + 16 * m + fr) * 32 + 16 + 4 * fq) = acc[m][1]; }
        __syncthreads();
        if (wv < RT) {
        const int rl = tid >> 2, q = tid & 3, r = rg * RR + rl, row = 16384 + r, b = 8 + r; f32x4 v0 = {0.f, 0.f, 0.f, 0.f}, v1 = {0.f, 0.f, 0.f, 0.f};
        const int o0 = (MODE == 0) ? 4 * q : 8 * q, o1 = (MODE == 0) ? 16 + 4 * q : 8 * q + 4;
#pragma unroll
        for (int w = 0; w < 8; ++w) { v0 += *(const f32x4*)(red + (size_t)(w * RR + rl) * 32 + o0); v1 += *(const f32x4*)(red + (size_t)(w * RR + rl) * 32 + o1); }
        if (MODE == 0) { const float rs = srow_rstd(ssqS, r); const float* cbr = a.cb + (size_t)b * CBLD;
            const f32x4 g = v0 * rs + *(const f32x4*)(cbr + n0 + 4 * q), uu = v1 * rs + *(const f32x4*)(cbr + n1 + 4 * q); f32x4 hh;
#pragma unroll
            for (int jj = 0; jj < 4; ++jj) hh[jj] = siluf_(g[jj]) * uu[jj];
            *(u32x2*)(a.O + (size_t)row * 2816 + (j >> 3) * 128 + (j & 7) * 16 + 4 * q) = pack4(hh); }
        else if (MODE == 1) { const int c = n0 + 8 * q; const float* modr = a.mod + (size_t)b * MODLD; bf16_t* xp = a.An + (size_t)row * 1024 + c; const u32x4 xw8 = *(const u32x4*)xp;
            const f32x4 p0 = *(const f32x4*)(a.pw + c) * (*(const f32x4*)(modr + a.poff + c) + 1.0f), p1 = *(const f32x4*)(a.pw + c + 4) * (*(const f32x4*)(modr + a.poff + c + 4) + 1.0f);
            f32x4 x0 = unpack4((u32x2){xw8.x, xw8.y}), x1 = unpack4((u32x2){xw8.z, xw8.w});
#pragma unroll
            for (int jj = 0; jj < 4; ++jj) { x0[jj] *= __builtin_amdgcn_rcpf(p0[jj]); x1[jj] *= __builtin_amdgcn_rcpf(p1[jj]); }
            const f32x4 g0 = *(const f32x4*)(modr + a.goff + c), g1 = *(const f32x4*)(modr + a.goff + c + 4);
            f32x4 a0 = {1.f, 1.f, 1.f, 1.f}, a1 = a0; if (a.nw) { a0 = *(const f32x4*)(a.nw + c) * (*(const f32x4*)(modr + a.soff + c) + 1.0f); a1 = *(const f32x4*)(a.nw + c + 4) * (*(const f32x4*)(modr + a.soff + c + 4) + 1.0f); }
            const f32x4 y0 = x0 + (g0 + 1.0f) * a.coef * v0, y1 = x1 + (g1 + 1.0f) * a.coef * v1;
            { const u32x2 pa = pack4(y0 * a0), pb = pack4(y1 * a1); *(u32x4*)xp = (u32x4){pa.x, pa.y, pb.x, pb.y}; }
            float ss = ((y0[0] * y0[0] + y0[1] * y0[1]) + (y0[2] * y0[2] + y0[3] * y0[3])) + ((y1[0] * y1[0] + y1[1] * y1[1]) + (y1[2] * y1[2] + y1[3] * y1[3]));
            ss += __shfl_xor(ss, 1); ss += __shfl_xor(ss, 2); if (q == 0) ssqS[r * 32 + j] = ss; }
        else { const int c = n0 + 8 * q; const float rs = srow_rstd(ssqS, r); const float* cbr = a.cb + (size_t)b * CBLD + c; f32x4 y0 = v0 * rs + *(const f32x4*)cbr, y1 = v1 * rs + *(const f32x4*)(cbr + 4);
            if (MODE == 3) {
#pragma unroll
                for (int jj = 0; jj < 4; ++jj) { y0[jj] = gelu_tanh(y0[jj]); y1[jj] = gelu_tanh(y1[jj]); }
                float s1 = ((y0[0] + y0[1]) + (y0[2] + y0[3])) + ((y1[0] + y1[1]) + (y1[2] + y1[3]));
                float s2 = ((y0[0] * y0[0] + y0[1] * y0[1]) + (y0[2] * y0[2] + y0[3] * y0[3])) + ((y1[0] * y1[0] + y1[1] * y1[1]) + (y1[2] * y1[2] + y1[3] * y1[3]));
                s1 += __shfl_xor(s1, 1); s1 += __shfl_xor(s1, 2); s2 += __shfl_xor(s2, 1); s2 += __shfl_xor(s2, 2);
                if (j >= 64 && q == 0) { lnpS[(r * 64 + (j - 64)) * 2] = s1; lnpS[(r * 64 + (j - 64)) * 2 + 1] = s2; } }
            const u32x2 pa = pack4(y0), pb = pack4(y1); *(u32x4*)(a.O + (size_t)row * 4096 + c) = (u32x4){pa.x, pa.y, pb.x, pb.y}; }
        }
        __syncthreads();
    }
}

__device__ void conv_job(const float* src, int K, int ldn, int N, int mode, bf16_t* dst, float* tile) {
    const int tid = tidx(); const int nkt = K >> 6, nt = nkt * (N >> 6);
    for (int t = blockIdx.x; t < nt; t += gridDim.x) {
        const int kt = t % nkt, ntile = t / nkt, n0 = ntile * 64, k0 = kt * 64;
        { const int nl = tid & 63, kk = tid >> 6, nd = n0 + nl; const int sc = mode ? (((nd >> 7) & 1) * 2816 + (nd >> 8) * 128 + (nd & 127)) : nd;
#pragma unroll
          for (int j = 0; j < 8; ++j) tile[(kk + 8 * j) * 65 + nl] = __builtin_nontemporal_load(src + (size_t)(k0 + kk + 8 * j) * ldn + sc); }
        __syncthreads();
        { const int k2 = (tid & 31) * 2, nr = tid >> 5;
#pragma unroll
          for (int j = 0; j < 4; ++j) { const int n = nr + 16 * j; *(unsigned*)(dst + (size_t)(n0 + n) * K + k0 + k2) = cvt_pk_bf16(tile[k2 * 65 + n], tile[(k2 + 1) * 65 + n]); } }
        __syncthreads();
    }
}
__device__ void phase_convert(const Params& p, unsigned char* lds) {
    float* tile = (float*)lds; bf16_t* W1 = (bf16_t*)(p.ws + OFF_W1);
    for (int i = 0; i < 4; ++i) {
        for (int f = 0; f < 2; ++f) {
            conv_job(p.w_gu + (size_t)(i * 2 + f) * 1024 * 5632, 1024, 5632, 5632, 1, W1 + (size_t)(i * 60 + (f ? 38 : 0)) * 256 * 1024, tile);
            conv_job(p.w_down + (size_t)(i * 2 + f) * 2816 * 1024, 2816, 1024, 1024, 0, (bf16_t*)(p.ws + OFF_WDN) + (size_t)(i * 2 + f) * 1024 * 2816, tile); }
        const int li = i >> 1;
        if ((i & 1) == 0) { conv_job(p.a_w_in + (size_t)li * 1024 * 4112, 1024, 4112, 4096, 0, W1 + (size_t)(i * 60 + 22) * 256 * 1024, tile);
                            conv_job(p.a_w_out + (size_t)li * 1024 * 1024, 1024, 1024, 1024, 0, (bf16_t*)(p.ws + OFF_WOA) + (size_t)li * 1024 * 1024, tile); }
        else { conv_job(p.b_w_in + (size_t)li * 1024 * 4096, 1024, 4096, 4096, 0, W1 + (size_t)(i * 60 + 22) * 256 * 1024, tile);
               conv_job(p.b_w_out + (size_t)li * 2048 * 1024, 2048, 1024, 1024, 0, (bf16_t*)(p.ws + OFF_WOB) + (size_t)li * 1024 * 2048, tile); }
        conv_job(p.w_ada + (size_t)i * 1024 * 9216, 1024, 9216, 9216, 0, (bf16_t*)(p.ws + OFF_R1) + (size_t)i * 9216 * 1024, tile);
    }
    const int gt = blockIdx.x * 512 + tidx(), gs = gridDim.x * 512;
    bf16_t* SC = (bf16_t*)(p.ws + OFF_SC);
    for (int e = gt; e < 256 * 1024; e += gs) { const int r = e >> 10, k = e & 1023; float v = 0.f; if (r < 8) v = p.c_prompt[r * 1024 + k]; else if (r < 136) v = p.c_sample[(r - 8) * 1024 + k]; SC[e] = f2bf(siluf_(v)); }
    float* WL = (float*)(p.ws + OFF_WLOG);
    for (int e = gt; e < 2 * 16 * 1024; e += gs) { const int li = e >> 14, j = (e >> 10) & 15, k = e & 1023; WL[e] = p.a_w_in[(size_t)li * 1024 * 4112 + (size_t)k * 4112 + 4096 + j]; }
}

__device__ void phase_prep0(const Params& p) {
    const int tid = tidx(), lane = tid & 63, gw = blockIdx.x * 8 + (tid >> 6), nw = gridDim.x * 8;
    const float* mod = (const float*)(p.ws + OFF_MOD);
    bf16_t* SH = (bf16_t*)(p.ws + OFF_SH);
    for (int e8 = blockIdx.x * 512 + tid; e8 < 12 * 256 * 128; e8 += gridDim.x * 512) { const int e = e8 * 8, site = e >> 18, r = (e >> 10) & 255, k = e & 1023; const int i = site / 3, sub = site % 3;
        f32x4 v0 = {0.f, 0.f, 0.f, 0.f}, v1 = v0; if (r < 136) { const float* q = mod + (size_t)r * MODLD + i * 9216 + sub * 3072 + k; v0 = *(const f32x4*)q; v1 = *(const f32x4*)(q + 4); }
        const u32x2 a = pack4(v0), b2 = pack4(v1); *(u32x4*)(SH + e) = (u32x4){a.x, a.y, b2.x, b2.y}; }
    bf16_t* An = (bf16_t*)(p.ws + OFF_AN); float* ssq = (float*)(p.ws + OFF_SSQ);
    for (int row = gw; row < MPAD; row += nw) {
        const float* src = row < 16384 ? p.x_prompt + (size_t)row * 1024 : (row < 16512 ? p.x_sample + (size_t)(row - 16384) * 1024 : nullptr);
        const int b = row_b(row); const float* modr = mod + (size_t)b * MODLD; float ss = 0.f;
#pragma unroll
        for (int j = 0; j < 4; ++j) { const int k = j * 256 + lane * 4; f32x4 x = {0.f, 0.f, 0.f, 0.f}; if (src) x = *(const f32x4*)(src + k);
            ss += (x[0] * x[0] + x[1] * x[1]) + (x[2] * x[2] + x[3] * x[3]);
            const f32x4 sc = *(const f32x4*)(modr + 1024 + k), w = *(const f32x4*)(p.norm_w + k); *(u32x2*)(An + (size_t)row * 1024 + k) = pack4(x * (w * (sc + 1.0f))); }
        ss = wsum(ss); if (row < 16384) { if (lane < 16) ssq[(size_t)row * 16 + lane] = lane == 0 ? ss : 0.f; } else if (row < 16512) { if (lane < 32) ((float*)(p.ws + OFF_SSQS))[(row - 16384) * 32 + lane] = lane == 0 ? ss : 0.f; }
    }
    const float* WL = (const float*)(p.ws + OFF_WLOG); float* cb16 = (float*)(p.ws + OFF_CB16);
    for (int t = gw; t < 2 * 136; t += nw) { const int li = t / 136, b = t % 136; const float* sh = mod + (size_t)b * MODLD + (2 * li) * 9216 + 3072;
        float shv[16];
#pragma unroll
        for (int kk = 0; kk < 16; ++kk) shv[kk] = sh[kk * 64 + lane];
#pragma unroll 1
        for (int j4 = 0; j4 < 16; j4 += 4) { float wv_[4][16];
#pragma unroll
            for (int jj = 0; jj < 4; ++jj)
#pragma unroll
                for (int kk = 0; kk < 16; ++kk) wv_[jj][kk] = WL[(size_t)(li * 16 + j4 + jj) * 1024 + kk * 64 + lane];
#pragma unroll
            for (int jj = 0; jj < 4; ++jj) { float s = 0.f;
#pragma unroll
                for (int kk = 0; kk < 16; ++kk) s += shv[kk] * wv_[jj][kk];
                s = wsum(s); if (lane == 0) cb16[t * 16 + j4 + jj] = s; } } }
}

__device__ void phase_final(const Params& p) {
    const int tid = tidx(), lane = tid & 63, gw = blockIdx.x * 8 + (tid >> 6), nw = gridDim.x * 8;
    const bf16_t* X = (const bf16_t*)(p.ws + OFF_AN); const float* ssq = (const float*)(p.ws + OFF_SSQ);
    for (int row = gw; row < 16512; row += nw) { const float rs = row < 16384 ? row_rstd(ssq, row) : srow_rstd((const float*)(p.ws + OFF_SSQS), row - 16384);
#pragma unroll
        for (int j = 0; j < 4; ++j) { const int k = j * 256 + lane * 4; const f32x4 x = unpack4(*(const u32x2*)(X + (size_t)row * 1024 + k)), w = *(const f32x4*)(p.final_w + k);
            *(f32x4*)(p.out + OUT_Y + (size_t)row * 1024 + k) = x * rs * w; } }
}

__device__ void prep_phase(const Params& p, int li, unsigned char* lds) {
    const int tid0 = tidx(), wv = __builtin_amdgcn_readfirstlane(tid0 >> 6);
    float* MT = (float*)lds; float* sm = (float*)(lds + 17408); bf16_t* kn = (bf16_t*)(lds + 19456); bf16_t* qn = (bf16_t*)(lds + 36864); bf16_t* at = (bf16_t*)(lds + 54272); float* vf = (float*)(lds + 63488); bf16_t* mb = (bf16_t*)(lds + 97280); bf16_t* db = (bf16_t*)(lds + 106496); bf16_t* wb = (bf16_t*)(lds + 109568);
    const bf16_t* PROJ = (const bf16_t*)(p.ws + OFF_PROJ); const bf16_t* An = (const bf16_t*)(p.ws + OFF_AN); const float* ssq = (const float*)(p.ws + OFF_SSQ);
    const float* WL = (const float*)(p.ws + OFF_WLOG); const float* cb16 = (const float*)(p.ws + OFF_CB16);
    const float* wconv = p.a_w_conv + (size_t)li * 4 * 3072;
    float* wl = (float*)(lds + 130048); int hcur = -1;
    for (int item = blockIdx.x; item < 2048; item += gridDim.x) {
        int tid_ = tid0; asm volatile("" : "+v"(tid_));
        const int tid = tid_, lane = tid & 63, fr = lane & 15, fq = lane >> 4;
        const int b = item >> 8, n = (item >> 3) & 31, h = item & 7; const int row0 = b * 2048 + n * 64;
        unsigned char* dst = p.ws + OFF_R1 + (size_t)item * ITEM_BYTES;
        if (h != hcur) { hcur = h;
            for (int e = tid; e < 2048; e += 512) { const int which = e >> 10, k = e & 1023; wl[which * 1056 + (k >> 7) * 132 + (k & 127)] = WL[(size_t)(li * 16 + which * 8 + h) * 1024 + k]; }
            lds_barrier(); }
#ifdef MK_PROBE_PREPFRONT
        for (int rep_ = 0; rep_ < 2; ++rep_) {
#endif
        if (wv < 6) { const int c8 = tid % 48, run = tid / 48, seg = c8 >> 4, ch = (c8 & 15) * 8, col = seg * 1024 + h * 128 + ch, tok0 = run * 8;
            u32x4 xr[11];
#pragma unroll
            for (int r = 0; r < 11; ++r) { const int pos = n * 64 + tok0 - 3 + r; xr[r] = (u32x4){0u, 0u, 0u, 0u}; if (pos >= 0) xr[r] = *(const u32x4*)(PROJ + (size_t)(b * 2048 + pos) * 4096 + col); }
            f32x4 cw[4][2];
#pragma unroll
            for (int j = 0; j < 4; ++j) { cw[j][0] = *(const f32x4*)(wconv + j * 3072 + col); cw[j][1] = *(const f32x4*)(wconv + j * 3072 + col + 4); }
#pragma unroll
            for (int t = 0; t < 8; ++t) { const int tok = tok0 + t; f32x4 a0 = {0.f, 0.f, 0.f, 0.f}, a1 = a0;
#pragma unroll
                for (int j = 0; j < 4; ++j) { a0 += unpack4((u32x2){xr[t + j].x, xr[t + j].y}) * cw[j][0]; a1 += unpack4((u32x2){xr[t + j].z, xr[t + j].w}) * cw[j][1]; }
                f32x4 s0, s1;
#pragma unroll
                for (int j = 0; j < 4; ++j) { s0[j] = siluf_(a0[j]); s1[j] = siluf_(a1[j]); }
                const float ss = row16_sum(((s0[0] * s0[0] + s0[1] * s0[1]) + (s0[2] * s0[2] + s0[3] * s0[3])) + ((s1[0] * s1[0] + s1[1] * s1[1]) + (s1[2] * s1[2] + s1[3] * s1[3])));
                const float rn = rsqrtf(ss + 1e-6f);
                if (seg == 0) { const float sc = rn * 0.08838834764831845f; const u32x2 pa = pack4(s0 * sc), pb = pack4(s1 * sc); *(u32x4*)(qn + tok * 136 + ch) = (u32x4){pa.x, pa.y, pb.x, pb.y}; }
                else if (seg == 1) { const u32x2 pa = pack4(s0 * rn), pb = pack4(s1 * rn); *(u32x4*)(kn + tok * 136 + ch) = (u32x4){pa.x, pa.y, pb.x, pb.y}; }
                else { *(f32x4*)(vf + tok * 132 + ch) = s0; *(f32x4*)(vf + tok * 132 + ch + 4) = s1; } } }
        { const int tok = tid >> 3, part = tid & 7, row = row0 + tok; const bf16_t* ar = An + (size_t)row * 1024 + part * 128;
          const float* w1 = wl + part * 132; const float* w2 = wl + 1056 + part * 132; float s1 = 0.f, s2 = 0.f;
#pragma unroll 1
          for (int kh = 0; kh < 2; ++kh) { u32x4 xw[8];
#pragma unroll
              for (int kk = 0; kk < 8; ++kk) xw[kk] = *(const u32x4*)(ar + (kh * 8 + kk) * 8);
#pragma unroll
              for (int kk = 0; kk < 8; ++kk) { const int ko = (kh * 8 + kk) * 8; const f32x4 x0 = unpack4((u32x2){xw[kk].x, xw[kk].y}), x1 = unpack4((u32x2){xw[kk].z, xw[kk].w});
                  const f32x4 a0 = *(const f32x4*)(w1 + ko), a1 = *(const f32x4*)(w1 + ko + 4), c0 = *(const f32x4*)(w2 + ko), c1 = *(const f32x4*)(w2 + ko + 4);
#pragma unroll
                  for (int j = 0; j < 4; ++j) { s1 += x0[j] * a0[j] + x1[j] * a1[j]; s2 += x0[j] * c0[j] + x1[j] * c1[j]; } } }
          s1 += __shfl_xor(s1, 1); s1 += __shfl_xor(s1, 2); s1 += __shfl_xor(s1, 4); s2 += __shfl_xor(s2, 1); s2 += __shfl_xor(s2, 2); s2 += __shfl_xor(s2, 4);
          if (part == 0) { const float rs = row_rstd(ssq, row); const float bl = rs * s1 + cb16[(li * 136 + b) * 16 + h], al = rs * s2 + cb16[(li * 136 + b) * 16 + 8 + h] + p.a_dt_bias[li * 8 + h];
              const float sp = fmaxf(al, 0.f) + log1pf(__expf(-fabsf(al))); sm[tok] = sigmoidf_(bl); sm[64 + tok] = -__expf(p.a_log[li * 8 + h]) * sp; } }
        lds_barrier();
        if (wv == 0) { float d = sm[64 + lane];
#pragma unroll
            for (int o = 1; o < 64; o <<= 1) { const float t = __shfl_up(d, o); if (lane >= o) d += t; }
            sm[128 + lane] = d; sm[192 + lane] = __expf(d); }
        lds_barrier();
        { const int gram = wv >> 2, i = wv & 3; const bf16_t* src = gram ? qn : kn; bf16x8 a[4];
#pragma unroll
          for (int t = 0; t < 4; ++t) a[t] = *(const bf16x8*)(src + (16 * i + fr) * 136 + 32 * t + 8 * fq);
          for (int j = 0; j < 4; ++j) { f32x4 acc = {0.f, 0.f, 0.f, 0.f};
              if (j <= i) {
#pragma unroll
                  for (int t = 0; t < 4; ++t) { const bf16x8 bb = *(const bf16x8*)(kn + (16 * j + fr) * 136 + 32 * t + 8 * fq); acc = __builtin_amdgcn_mfma_f32_16x16x32_bf16(a[t], bb, acc, 0, 0, 0); } }
              const int s = 16 * j + fr; const float ds = sm[128 + s];
#pragma unroll
              for (int idx = 0; idx < 4; ++idx) { const int c = 16 * i + 4 * fq + idx; const float gam = __expf(sm[128 + c] - ds);
                  if (gram == 0) { const float mv = (c > s) ? sm[c] * acc[idx] * gam : 0.f; MT[s * 68 + c] = mv; mb[c * 72 + s] = f2bf(mv); }
                  else at[c * 72 + s] = f2bf((c >= s) ? acc[idx] * gam : 0.f); } } }
        lds_barrier();
#ifdef MK_PROBE_PREPFRONT
        }
#endif
        if (wv == 0) { const int bi_ = lane >> 4, cc = lane & 15; const float* Md = MT + (16 * bi_) * 68 + 16 * bi_; float x[16];
#pragma unroll
            for (int r = 0; r < 16; ++r) x[r] = (r == cc) ? 1.0f : 0.0f;
#pragma unroll
            for (int q = 0; q < 15; ++q) { f32x4 mr[4];
#pragma unroll
                for (int g4 = 0; g4 < 4; ++g4) if (4 * g4 + 3 > q) mr[g4] = *(const f32x4*)(Md + q * 68 + 4 * g4);
#pragma unroll
                for (int r = q + 1; r < 16; ++r) x[r] -= mr[r >> 2][r & 3] * x[q]; }
#pragma unroll
            for (int r = 0; r < 16; ++r) db[(bi_ * 16 + r) * 24 + cc] = f2bf(x[r]);
        } else {
            const int t2 = tid - 64; const float dl = sm[128 + 63];
            for (int e = t2; e < 1024; e += 448) { const int ln = e & 63, f = e >> 6, i = f >> 2, t = f & 3, r_ = ln & 15, q_ = ln >> 4; const int c = 16 * i + r_; const float sc = sm[192 + c];
                const u32x2 lo = *(const u32x2*)(qn + c * 136 + 32 * t + 4 * q_), hi = *(const u32x2*)(qn + c * 136 + 32 * t + 16 + 4 * q_);
                const u32x2 a = pack4(unpack4(lo) * sc), bq = pack4(unpack4(hi) * sc); *(u32x4*)(dst + 16384 + (size_t)e * 16) = (u32x4){a.x, a.y, bq.x, bq.y}; }
            for (int e = t2; e < 1024; e += 448) { const int ln = e & 63, f = e >> 6, j = f >> 1, tt = f & 1, r_ = ln & 15, q_ = ln >> 4; const int kd = 16 * j + r_; f32x4 lo, hi;
#pragma unroll
                for (int s = 0; s < 4; ++s) { const int c0 = 32 * tt + 4 * q_ + s, c1 = c0 + 16; lo[s] = bf2f(kn[c0 * 136 + kd]) * __expf(dl - sm[128 + c0]); hi[s] = bf2f(kn[c1 * 136 + kd]) * __expf(dl - sm[128 + c1]); }
                const u32x2 a = pack4(lo), bq = pack4(hi); *(u32x4*)(dst + 32768 + (size_t)e * 16) = (u32x4){a.x, a.y, bq.x, bq.y}; }
            for (int e = t2; e < 512; e += 448) { const int ln = e & 63, f = e >> 6, i = f >> 1, tt = f & 1, r_ = ln & 15, q_ = ln >> 4; const int c = 16 * i + r_;
                const u32x2 lo = *(const u32x2*)(at + c * 72 + 32 * tt + 4 * q_), hi = *(const u32x2*)(at + c * 72 + 32 * tt + 16 + 4 * q_);
                *(u32x4*)(dst + 49152 + (size_t)e * 16) = (u32x4){lo.x, lo.y, hi.x, hi.y}; }
            if (t2 == 0) *(float*)(dst + 73728) = __expf(dl);
        }
        lds_barrier();
        { f32x4 sol[4][2]; const bool isv = wv < 4;
#pragma unroll
          for (int ib = 0; ib < 4; ++ib) { f32x4 R[2]; __builtin_amdgcn_sched_barrier(0);
#pragma unroll
              for (int ct = 0; ct < 2; ++ct) { const int colg = 32 * wv + 16 * ct + fr;
#pragma unroll
                  for (int idx = 0; idx < 4; ++idx) { const int c = 16 * ib + 4 * fq + idx; const float rv = vf[c * 132 + (colg & 127)], rk_ = bf2f(kn[c * 136 + (colg & 127)]) * sm[192 + c]; R[ct][idx] = (isv ? rv : rk_) * sm[c]; } }
              if (ib > 0) { f32x4 P[2] = {{0.f, 0.f, 0.f, 0.f}, {0.f, 0.f, 0.f, 0.f}};
#pragma unroll
                  for (int t = 0; t <= (ib - 1) / 2; ++t) { const bool two = (2 * t + 1 < ib);
                      const u32x2 lo = *(const u32x2*)(mb + (16 * ib + fr) * 72 + 32 * t + 4 * fq); u32x2 hi = {0u, 0u}; if (two) hi = *(const u32x2*)(mb + (16 * ib + fr) * 72 + 32 * t + 16 + 4 * fq);
                      const bf16x8 af = __builtin_bit_cast(bf16x8, (u32x4){lo.x, lo.y, hi.x, hi.y});
#pragma unroll
                      for (int ct = 0; ct < 2; ++ct) { const f32x4 z4 = {0.f, 0.f, 0.f, 0.f}; const bf16x8 bfg = pack8(sol[2 * t][ct], two ? sol[2 * t + 1][ct] : z4);
                          P[ct] = __builtin_amdgcn_mfma_f32_16x16x32_bf16(af, bfg, P[ct], 0, 0, 0); } }
                  R[0] = R[0] - P[0]; R[1] = R[1] - P[1]; }
              { const u32x2 lo = *(const u32x2*)(db + (ib * 16 + fr) * 24 + 4 * fq); const bf16x8 df = __builtin_bit_cast(bf16x8, (u32x4){lo.x, lo.y, 0u, 0u});
#pragma unroll
                for (int ct = 0; ct < 2; ++ct) { const f32x4 z4 = {0.f, 0.f, 0.f, 0.f}; sol[ib][ct] = __builtin_amdgcn_mfma_f32_16x16x32_bf16(df, pack8(R[ct], z4), z4, 0, 0, 0); } } }
          if (isv) {
#pragma unroll
              for (int ib = 0; ib < 4; ++ib)
#pragma unroll
                  for (int ct = 0; ct < 2; ++ct) *(u32x2*)(dst + 57344 + (size_t)((ib * 8 + 2 * wv + ct) * 64 + lane) * 8) = pack4(sol[ib][ct]);
          } else {
#pragma unroll
              for (int ib = 0; ib < 4; ++ib)
#pragma unroll
                  for (int ct = 0; ct < 2; ++ct)
#pragma unroll
                      for (int idx = 0; idx < 4; ++idx) wb[(16 * ib + 4 * fq + idx) * 136 + 32 * (wv - 4) + 16 * ct + fr] = f2bf(sol[ib][ct][idx]); } }
        lds_barrier();
        for (int e = tid; e < 1024; e += 512) { const int ln = e & 63, f = e >> 6, i = f >> 2, t = f & 3, r_ = ln & 15, q_ = ln >> 4; const int c = 16 * i + r_;
            const u32x2 lo = *(const u32x2*)(wb + c * 136 + 32 * t + 4 * q_), hi = *(const u32x2*)(wb + c * 136 + 32 * t + 16 + 4 * q_);
            *(u32x4*)(dst + (size_t)e * 16) = (u32x4){lo.x, lo.y, hi.x, hi.y}; }
        lds_barrier();
    }
    for (int e = blockIdx.x * 512 + tid0; e < 8 * 3 * 3072; e += gridDim.x * 512) { const int b = e / 9216, r = (e / 3072) % 3, col = e % 3072;
        p.out[OUT_CONVP + ((size_t)(li * 8 + b) * 3 + r) * 3072 + col] = bf2f(PROJ[(size_t)(b * 2048 + 2045 + r) * 4096 + col]); }
}

__device__ void scan_block(const Params& p, int li, int bh, unsigned char* lds) {
    const int tid = tidx(), lane = tid & 63, wv = __builtin_amdgcn_readfirstlane(tid >> 6), fr = lane & 15, fq = lane >> 4; const int b = bh >> 3, h = bh & 7;
    float* red = (float*)(lds + 114688);
    const bf16_t* PROJ = (const bf16_t*)(p.ws + OFF_PROJ); bf16_t* OA = (bf16_t*)(p.ws + OFF_OAB);
    const unsigned char* base = p.ws + OFF_R1 + (size_t)((b * 32) * 8 + h) * ITEM_BYTES; const size_t cstride = 8 * ITEM_BYTES;
    f32x4 S[8];
#pragma unroll
    for (int j = 0; j < 8; ++j) S[j] = (f32x4){0.f, 0.f, 0.f, 0.f};
    u32x4 st[7]; u32x2 ucur[4], unext[4]; float elc, eln;
#pragma unroll
    for (int j = 0; j < 7; ++j) st[j] = *(const u32x4*)(base + (size_t)(j * 512 + tid) * 16);
#pragma unroll
    for (int i = 0; i < 4; ++i) ucur[i] = *(const u32x2*)(base + 57344 + (size_t)((i * 8 + wv) * 64 + lane) * 8);
    elc = *(const float*)(base + 73728);
#pragma unroll
    for (int j = 0; j < 7; ++j) *(u32x4*)(lds + (size_t)(j * 512 + tid) * 16) = st[j];
    lds_barrier();
    const f32x4 wn4 = *(const f32x4*)(p.a_w_onorm + li * 128 + 16 * wv + 4 * fq);
    for (int n = 0; n < 32; ++n) {
        const unsigned char* nb = base + (size_t)(n + 1) * cstride;
        if (n + 1 < 32) {
#pragma unroll
            for (int j = 0; j < 7; ++j) st[j] = *(const u32x4*)(nb + (size_t)(j * 512 + tid) * 16);
#pragma unroll
            for (int i = 0; i < 4; ++i) unext[i] = *(const u32x2*)(nb + 57344 + (size_t)((i * 8 + wv) * 64 + lane) * 8);
            eln = *(const float*)(nb + 73728);
        }
        u32x2 zv[4];
#pragma unroll
        for (int i = 0; i < 4; ++i) zv[i] = *(const u32x2*)(PROJ + ((size_t)b * 2048 + n * 64 + 16 * i + fr) * 4096 + 3072 + h * 128 + 16 * wv + 4 * fq);
        const unsigned char* buf = lds + (size_t)(n & 1) * 57344;
        bf16x8 Sb[4];
#pragma unroll
        for (int t = 0; t < 4; ++t) Sb[t] = pack8(S[2 * t], S[2 * t + 1]);
        f32x4 vnew[4];
#pragma unroll
        for (int i = 0; i < 4; ++i) vnew[i] = (f32x4){0.f, 0.f, 0.f, 0.f};
#pragma unroll
        for (int th = 0; th < 2; ++th) { bf16x8 wf[8];
#pragma unroll
            for (int f = 0; f < 8; ++f) wf[f] = *(const bf16x8*)(buf + (size_t)(((f >> 1) * 4 + 2 * th + (f & 1)) * 64 + lane) * 16);
            __builtin_amdgcn_sched_barrier(0);
#pragma unroll
            for (int tt = 0; tt < 2; ++tt)
#pragma unroll
                for (int i = 0; i < 4; ++i) vnew[i] = __builtin_amdgcn_mfma_f32_16x16x32_bf16(wf[i * 2 + tt], Sb[2 * th + tt], vnew[i], 0, 0, 0);
            __builtin_amdgcn_sched_barrier(0); }
#pragma unroll
        for (int i = 0; i < 4; ++i) vnew[i] = unpack4(ucur[i]) - vnew[i];
        bf16x8 vb[2];
#pragma unroll
        for (int t = 0; t < 2; ++t) vb[t] = pack8(vnew[2 * t], vnew[2 * t + 1]);
        f32x4 o[4];
#pragma unroll
        for (int i = 0; i < 4; ++i) o[i] = (f32x4){0.f, 0.f, 0.f, 0.f};
#pragma unroll
        for (int th = 0; th < 2; ++th) { bf16x8 qf[8];
#pragma unroll
            for (int f = 0; f < 8; ++f) qf[f] = *(const bf16x8*)(buf + 16384 + (size_t)(((f >> 1) * 4 + 2 * th + (f & 1)) * 64 + lane) * 16);
            __builtin_amdgcn_sched_barrier(0);
#pragma unroll
            for (int tt = 0; tt < 2; ++tt)
#pragma unroll
                for (int i = 0; i < 4; ++i) o[i] = __builtin_amdgcn_mfma_f32_16x16x32_bf16(Sb[2 * th + tt], qf[i * 2 + tt], o[i], 0, 0, 0);
            __builtin_amdgcn_sched_barrier(0); }
        { bf16x8 af[8];
#pragma unroll
          for (int f = 0; f < 8; ++f) af[f] = *(const bf16x8*)(buf + 49152 + (size_t)(f * 64 + lane) * 16);
          __builtin_amdgcn_sched_barrier(0);
#pragma unroll
          for (int t = 0; t < 2; ++t)
#pragma unroll
              for (int i = 0; i < 4; ++i) o[i] = __builtin_amdgcn_mfma_f32_16x16x32_bf16(vb[t], af[i * 2 + t], o[i], 0, 0, 0);
          __builtin_amdgcn_sched_barrier(0); }
#pragma unroll
        for (int jh = 0; jh < 2; ++jh) { bf16x8 kf[8];
#pragma unroll
            for (int f = 0; f < 8; ++f) kf[f] = *(const bf16x8*)(buf + 32768 + (size_t)((jh * 8 + f) * 64 + lane) * 16);
            __builtin_amdgcn_sched_barrier(0);
#pragma unroll
            for (int jj = 0; jj < 4; ++jj) S[jh * 4 + jj] = S[jh * 4 + jj] * elc;
#pragma unroll
            for (int t = 0; t < 2; ++t)
#pragma unroll
                for (int jj = 0; jj < 4; ++jj) S[jh * 4 + jj] = __builtin_amdgcn_mfma_f32_16x16x32_bf16(kf[jj * 2 + t], vb[t], S[jh * 4 + jj], 0, 0, 0);
            __builtin_amdgcn_sched_barrier(0); }
        float* rd = red + (n & 1) * 512;
        { float qs[4];
#pragma unroll
          for (int i = 0; i < 4; ++i) { float q = (o[i][0] * o[i][0] + o[i][1] * o[i][1]) + (o[i][2] * o[i][2] + o[i][3] * o[i][3]); q += __shfl_xor(q, 16); q += __shfl_xor(q, 32); qs[i] = q; }
          if (fq == 0) {
#pragma unroll
              for (int i = 0; i < 4; ++i) rd[(16 * i + fr) * 8 + wv] = qs[i]; } }
        if (n + 1 < 32) { unsigned char* ob = lds + (size_t)((n + 1) & 1) * 57344;
#pragma unroll
            for (int j = 0; j < 7; ++j) *(u32x4*)(ob + (size_t)(j * 512 + tid) * 16) = st[j]; }
        lds_barrier();
        { f32x4 r0[4], r1[4];
#pragma unroll
          for (int i = 0; i < 4; ++i) { const int c = 16 * i + fr; r0[i] = *(const f32x4*)(rd + c * 8); r1[i] = *(const f32x4*)(rd + c * 8 + 4); }
#pragma unroll
          for (int i = 0; i < 4; ++i) { const int c = 16 * i + fr;
              const float ssq_ = ((r0[i][0] + r0[i][1]) + (r0[i][2] + r0[i][3])) + ((r1[i][0] + r1[i][1]) + (r1[i][2] + r1[i][3])); const float rs = rsqrtf(ssq_ * (1.0f / 128.0f) + 1e-6f);
              const size_t row = (size_t)b * 2048 + n * 64 + c; const f32x4 z = unpack4(zv[i]); f32x4 y;
#pragma unroll
              for (int idx = 0; idx < 4; ++idx) y[idx] = o[i][idx] * rs * wn4[idx] * siluf_(z[idx]);
              *(u32x2*)(OA + row * 1024 + h * 128 + 16 * wv + 4 * fq) = pack4(y); } }
        if (n + 1 < 32) {
#pragma unroll
            for (int i = 0; i < 4; ++i) ucur[i] = unext[i];
            elc = eln; }
    }
    float* So = p.out + OUT_SP + (size_t)((li * 8 + b) * 8 + h) * 16384;
#pragma unroll
    for (int j = 0; j < 8; ++j)
#pragma unroll
        for (int idx = 0; idx < 4; ++idx) So[(16 * j + 4 * fq + idx) * 128 + 16 * wv + fr] = S[j][idx];
    lds_barrier();
}

__device__ void sampleA_item(const Params& p, int li, int sb, int h, unsigned char* lds) {
    const int tid = tidx(), lane = tid & 63, wv = __builtin_amdgcn_readfirstlane(tid >> 6); const int row = 16384 + sb;
    float* qkv = (float*)lds; float* redA = qkv + 384; float* red1 = redA + 64; float* red2 = red1 + 512; float* scal = red2 + 512;
    const bf16_t* PROJ = (const bf16_t*)(p.ws + OFF_PROJ); const bf16_t* An = (const bf16_t*)(p.ws + OFF_AN); bf16_t* OA = (bf16_t*)(p.ws + OFF_OAB);
    if (tid < 384) { const int seg = tid >> 7, ch = tid & 127, col = seg * 1024 + h * 128 + ch; const float* stc = p.st_conv + (size_t)(li * 128 + sb) * 3 * 3072 + col;
        const float s0 = stc[0], s1 = stc[3072], s2 = stc[6144], xn = bf2f(PROJ[(size_t)row * 4096 + col]); const float* w = p.a_w_conv + (size_t)li * 4 * 3072 + col;
        qkv[tid] = siluf_(s0 * w[0] + s1 * w[3072] + s2 * w[6144] + xn * w[9216]);
        float* co = p.out + OUT_CONVS + (size_t)(li * 128 + sb) * 3 * 3072 + col; co[0] = s1; co[3072] = s2; co[6144] = xn; }
    { const float* WL = (const float*)(p.ws + OFF_WLOG); const int k = tid * 2; const float x0 = bf2f(An[(size_t)row * 1024 + k]), x1 = bf2f(An[(size_t)row * 1024 + k + 1]);
      const float* w1 = WL + (size_t)(li * 16 + h) * 1024 + k; const float* w2 = WL + (size_t)(li * 16 + 8 + h) * 1024 + k;
      float s1 = x0 * w1[0] + x1 * w1[1], s2 = x0 * w2[0] + x1 * w2[1]; s1 = wsum(s1); s2 = wsum(s2); if (lane == 0) { redA[wv] = s1; redA[8 + wv] = s2; } }
    __syncthreads();
    if (wv == 0) { float q = qkv[lane] * qkv[lane] + qkv[64 + lane] * qkv[64 + lane]; q = wsum(q); if (lane == 0) scal[0] = rsqrtf(q + 1e-6f) * 0.08838834764831845f; }
    if (wv == 1) { float q = qkv[128 + lane] * qkv[128 + lane] + qkv[192 + lane] * qkv[192 + lane]; q = wsum(q); if (lane == 0) scal[1] = rsqrtf(q + 1e-6f); }
    if (tid == 128) { float s1 = 0.f, s2 = 0.f; for (int j = 0; j < 8; ++j) { s1 += redA[j]; s2 += redA[8 + j]; }
        const float rs = srow_rstd((const float*)(p.ws + OFF_SSQS), sb); const float* cb16 = (const float*)(p.ws + OFF_CB16) + (size_t)(li * 136 + 8 + sb) * 16;
        const float bl = rs * s1 + cb16[h], al = rs * s2 + cb16[8 + h] + p.a_dt_bias[li * 8 + h]; const float sp = fmaxf(al, 0.f) + log1pf(__expf(-fabsf(al)));
        scal[2] = sigmoidf_(bl); scal[3] = __expf(-__expf(p.a_log[li * 8 + h]) * sp); }
    __syncthreads();
    const float rq = scal[0], rk = scal[1], beta = scal[2], eg = scal[3];
    const int v = tid & 127, kq = tid >> 7;
    const float* S0 = p.st_S + ((size_t)((li * 128 + sb) * 8 + h) * 128 + kq * 32) * 128 + v; float s[32]; float part = 0.f;
#pragma unroll
    for (int kk = 0; kk < 32; ++kk) { s[kk] = __builtin_nontemporal_load(S0 + kk * 128); part += s[kk] * (qkv[128 + kq * 32 + kk] * rk); }
    red1[kq * 128 + v] = part;
    __syncthreads();
    const float kv = (red1[v] + red1[128 + v]) + (red1[256 + v] + red1[384 + v]); const float vnew = beta * (qkv[256 + v] - eg * kv);
    float* So = p.out + OUT_SS + ((size_t)((li * 128 + sb) * 8 + h) * 128 + kq * 32) * 128 + v; float po = 0.f;
#pragma unroll
    for (int kk = 0; kk < 32; ++kk) { const float sn = eg * s[kk] + (qkv[128 + kq * 32 + kk] * rk) * vnew; __builtin_nontemporal_store(sn, So + kk * 128); po += sn * (qkv[kq * 32 + kk] * rq); }
    red2[kq * 128 + v] = po;
    __syncthreads();
    float o = 0.f;
    if (tid < 128) { o = (red2[v] + red2[128 + v]) + (red2[256 + v] + red2[384 + v]); const float q = wsum(o * o); if (lane == 0) scal[4 + wv] = q; }
    __syncthreads();
    if (tid < 128) { const float rs = rsqrtf((scal[4] + scal[5]) * (1.0f / 128.0f) + 1e-6f); const float z = bf2f(PROJ[(size_t)row * 4096 + 3072 + h * 128 + v]);
        OA[(size_t)row * 1024 + h * 128 + v] = f2bf(o * rs * p.a_w_onorm[li * 128 + v] * siluf_(z)); }
    __syncthreads();
}

__device__ void mixB_phase(const Params& p, int li, unsigned char* lds) {
    const int tid = tidx(), lane = tid & 63, wv = __builtin_amdgcn_readfirstlane(tid >> 6), fr = lane & 15, fq = lane >> 4;
    bf16_t* vT = (bf16_t*)lds; float* stt = (float*)(lds + 69632);
    const bf16_t* UV = (const bf16_t*)(p.ws + OFF_PROJ); bf16_t* OB = (bf16_t*)(p.ws + OFF_OAB); const float* lnp = (const float*)(p.ws + OFF_LNP);
    const float* vw = p.b_vnorm_w + li * 2048; const float* vbias = p.b_vnorm_b + li * 2048;
    { const int gw = blockIdx.x * 8 + wv; if (gw < 128) { const int row = 16384 + gw; const float* lnpS = (const float*)(p.ws + OFF_LNPS); float s1 = lnpS[(gw * 64 + lane) * 2], s2 = lnpS[(gw * 64 + lane) * 2 + 1];
        s1 = wsum(s1); s2 = wsum(s2); const float mean = s1 * (1.0f / 2048.0f), rstd = rsqrtf(fmaxf(s2 * (1.0f / 2048.0f) - mean * mean, 0.f) + 1e-6f);
#pragma unroll
        for (int jj = 0; jj < 4; ++jj) { const int c = (jj * 64 + lane) * 8, g = c >> 8; const u32x4 vw4 = *(const u32x4*)(UV + (size_t)row * 4096 + 2048 + c), uw4 = *(const u32x4*)(UV + (size_t)row * 4096 + c);
            const f32x4 v0 = unpack4((u32x2){vw4.x, vw4.y}), v1 = unpack4((u32x2){vw4.z, vw4.w}), u0 = unpack4((u32x2){uw4.x, uw4.y}), u1 = unpack4((u32x2){uw4.z, uw4.w});
            const f32x4 n0 = (v0 - mean) * rstd * *(const f32x4*)(vw + c) + *(const f32x4*)(vbias + c), n1 = (v1 - mean) * rstd * *(const f32x4*)(vw + c + 4) + *(const f32x4*)(vbias + c + 4);
            float* vo = p.out + OUT_VS + (size_t)(li * 128 + gw) * 2048 + c; *(f32x4*)vo = n0; *(f32x4*)(vo + 4) = n1;
            const float w00 = p.b_w_s[(size_t)(li * 8 + g) * 16384], bs0 = p.b_b_s[(li * 8 + g) * 128];
            const f32x4 m0 = n0 * w00 + bs0, m1 = n1 * w00 + bs0; const u32x2 a = pack4(u0 * m0), bq = pack4(u1 * m1);
            *(u32x4*)(OB + (size_t)row * 2048 + c) = (u32x4){a.x, a.y, bq.x, bq.y}; } } }
    for (int item = blockIdx.x; item < 1024; item += gridDim.x) {
        const int b = item >> 7, n = (item >> 3) & 15, g = item & 7; const int row0 = b * 2048 + n * 128;
        if (tid < 128) { const float* q = lnp + (size_t)(row0 + tid) * 64; float s1 = 0.f, s2 = 0.f;
#pragma unroll
            for (int j = 0; j < 16; ++j) { const f32x4 t = *(const f32x4*)(q + 4 * j); s1 += t[0] + t[2]; s2 += t[1] + t[3]; }
            const float mean = s1 * (1.0f / 2048.0f); stt[tid] = mean; stt[128 + tid] = rsqrtf(fmaxf(s2 * (1.0f / 2048.0f) - mean * mean, 0.f) + 1e-6f); }
        __syncthreads();
#pragma unroll 2
        for (int j = 0; j < 8; ++j) { const int e = tid + 512 * j, s = e & 127, d8 = (e >> 7) * 8; const u32x4 xw = *(const u32x4*)(UV + (size_t)(row0 + s) * 4096 + 2048 + g * 256 + d8);
            const f32x4 x0 = unpack4((u32x2){xw.x, xw.y}), x1 = unpack4((u32x2){xw.z, xw.w}); const float mean = stt[s], rstd = stt[128 + s];
            const f32x4 n0 = (x0 - mean) * rstd * *(const f32x4*)(vw + g * 256 + d8) + *(const f32x4*)(vbias + g * 256 + d8), n1 = (x1 - mean) * rstd * *(const f32x4*)(vw + g * 256 + d8 + 4) + *(const f32x4*)(vbias + g * 256 + d8 + 4);
#pragma unroll
            for (int jj = 0; jj < 4; ++jj) { vT[(d8 + jj) * 136 + s] = f2bf(n0[jj]); vT[(d8 + 4 + jj) * 136 + s] = f2bf(n1[jj]); } }
        __syncthreads();
        { const int i = wv; f32x4 acc[16];
#pragma unroll
          for (int j = 0; j < 16; ++j) acc[j] = (f32x4){0.f, 0.f, 0.f, 0.f};
          const int t = 16 * i + fr; const float* wsr = p.b_w_s + ((size_t)(li * 8 + g) * 128 + t) * 128;
          const int rp0 = 8 * (fr >> 2) + (fr & 3), rp1 = rp0 + 4;
          u32x4 uu[8];
#pragma unroll
          for (int pp = 0; pp < 8; ++pp) uu[pp] = *(const u32x4*)(UV + ((size_t)row0 + t) * 4096 + g * 256 + 32 * pp + 8 * fq);
          for (int ks = 0; ks <= (i >> 1); ++ks) { const int s0 = 32 * ks + 8 * fq; f32x4 w0 = *(const f32x4*)(wsr + s0), w1 = *(const f32x4*)(wsr + s0 + 4);
#pragma unroll
              for (int jj = 0; jj < 4; ++jj) { if (s0 + jj > t) w0[jj] = 0.f; if (s0 + 4 + jj > t) w1[jj] = 0.f; }
              const bf16x8 wf = pack8(w0, w1);
#pragma unroll
              for (int j = 0; j < 16; ++j) { const int vrow = 32 * (j >> 1) + ((j & 1) ? rp1 : rp0); const bf16x8 vfr = *(const bf16x8*)(vT + vrow * 136 + 32 * ks + 8 * fq); acc[j] = __builtin_amdgcn_mfma_f32_16x16x32_bf16(vfr, wf, acc[j], 0, 0, 0); } }
          const float bias = p.b_b_s[(li * 8 + g) * 128 + t]; const size_t row = (size_t)row0 + t;
#pragma unroll
          for (int pp = 0; pp < 8; ++pp) { const u32x2 pa = pack4(unpack4((u32x2){uu[pp].x, uu[pp].y}) * (acc[2 * pp] + bias)), pb = pack4(unpack4((u32x2){uu[pp].z, uu[pp].w}) * (acc[2 * pp + 1] + bias));
              *(u32x4*)(OB + row * 2048 + g * 256 + 32 * pp + 8 * fq) = (u32x4){pa.x, pa.y, pb.x, pb.y}; } }
        __syncthreads();
    }
}

__host__ __device__ __forceinline__ void decode_phase(int ph, int& kind, int& layer, int& f) {
    layer = 0; f = 0;
    if (ph < 4) { kind = ph; return; }
    if (ph == NPHASE - 1) { kind = 11; return; }
    int q = ph - 4, s; if (q < 8) { layer = 0; s = q; } else if (q < 15) { layer = 1; s = q - 8; } else if (q < 23) { layer = 2; s = q - 15; } else { layer = 3; s = q - 23; }
    if ((layer & 1) == 0) { f = s >= 6; kind = (s == 0 || s == 6) ? 4 : (s == 1 || s == 7) ? 5 : (s == 2) ? 6 : (s == 3) ? 7 : (s == 4) ? 8 : 10; }
    else { f = s >= 5; kind = (s == 0 || s == 5) ? 4 : (s == 1 || s == 6) ? 5 : (s == 2) ? 6 : (s == 3) ? 9 : 10; }
}
template <int KIND> __device__ __forceinline__ void run_kind(const Params& p, int layer, int f, unsigned char* lds) {
    PG8_LAS unsigned char* ldsl = (PG8_LAS unsigned char*)lds;
    unsigned char* ws = p.ws; const int G = gridDim.x, cid = blockIdx.x;
    bf16_t* W1 = (bf16_t*)(ws + OFF_W1); float* mod = (float*)(ws + OFF_MOD); float* cb = (float*)(ws + OFF_CB); bf16_t* An = (bf16_t*)(ws + OFF_AN);
    float* ssq = (float*)(ws + OFF_SSQ); bf16_t* ACTB = (bf16_t*)(ws + OFF_R1); bf16_t* PROJ = (bf16_t*)(ws + OFF_PROJ); bf16_t* OAB = (bf16_t*)(ws + OFF_OAB);
    const int li = layer >> 1;
    if constexpr (KIND == 0) { phase_convert(p, lds); }
    else if constexpr (KIND == 1) { pg8::Gemm g{(const bf16_t*)(ws + OFF_SC), (const bf16_t*)(ws + OFF_R1), 256, MODLD, 1024}; pg8::StaticOrder S; S.init(256, MODLD, G, cid); EpiMod E{mod, p.b_ada};
        pg8::gemm_phase<EpiMod, pg8::StaticOrder>(ldsl, g, S, E, nullptr); }
    else if constexpr (KIND == 2) { phase_prep0(p); }
    else if constexpr (KIND == 3) { pg8::Gemm g{(const bf16_t*)(ws + OFF_SH), W1, 3072, CBLD, 1024}; CbOrder S{G, cid}; EpiCb E{cb};
        pg8::gemm_phase<EpiCb, CbOrder>(ldsl, g, S, E, nullptr); }
    else if constexpr (KIND == 4) { const int t0 = layer * 60 + (f ? 38 : 0); pg8::Gemm g{An, W1 + (size_t)t0 * 256 * 1024, 16384, 5632, 1024}; pg8::StaticOrder S; S.init(16384, 5632, G, cid);
        SkArgs a{}; a.A = An + (size_t)16384 * 1024; a.Bt = g.Bt; a.K = 1024; a.N = 5632; a.cb = cb + (size_t)t0 * 256; a.O = ACTB; skinny_phase<0, 8>(p, a, 0, lds);
        EpiSwiglu E{ACTB, ssq, cb + (size_t)t0 * 256}; pg8::gemm_phase<EpiSwiglu, pg8::StaticOrder>(ldsl, g, S, E, nullptr); }
    else if constexpr (KIND == 13) { const int t0 = layer * 60 + (f ? 38 : 0); pg8::Gemm g{An, W1 + (size_t)t0 * 256 * 1024, 16384, 5632, 1024}; pg8::StaticOrder S; S.init(16384, 5632, G, cid);
        EpiDummy E{PROJ}; pg8::gemm_phase<EpiDummy, pg8::StaticOrder>(ldsl, g, S, E, nullptr); }
    else if constexpr (KIND == 5 || KIND == 10) {
        pg8::Gemm g; EpiResid E; E.An = An; E.ssq = ssq; E.mod = mod;
        if (KIND == 5) { g = pg8::Gemm{ACTB, (const bf16_t*)(ws + OFF_WDN) + (size_t)(layer * 2 + f) * 1024 * 2816, 16384, 1024, 2816}; E.goff = layer * 9216 + (f ? 2 : 0) * 3072 + 2048; E.coef = 0.5f; E.pw = p.norm_w + (layer * 3 + (f ? 2 : 0)) * 1024; E.poff = layer * 9216 + (f ? 2 : 0) * 3072 + 1024;
            if (!f) { E.nw = p.norm_w + (layer * 3 + 1) * 1024; E.soff = layer * 9216 + 3072 + 1024; }
            else if (layer < 3) { E.nw = p.norm_w + ((layer + 1) * 3) * 1024; E.soff = (layer + 1) * 9216 + 1024; }
            else { E.nw = nullptr; E.soff = 0; } }
        else { g = pg8::Gemm{OAB, (layer & 1) ? (const bf16_t*)(ws + OFF_WOB) + (size_t)li * 1024 * 2048 : (const bf16_t*)(ws + OFF_WOA) + (size_t)li * 1024 * 1024, 16384, 1024, (layer & 1) ? 2048 : 1024};
            E.goff = layer * 9216 + 3072 + 2048; E.coef = 1.0f; E.nw = p.norm_w + (layer * 3 + 2) * 1024; E.soff = layer * 9216 + 2 * 3072 + 1024; E.pw = p.norm_w + (layer * 3 + 1) * 1024; E.poff = layer * 9216 + 3072 + 1024; }
        g.M = 16384; pg8::StaticOrder S; S.init(16384, 1024, G, cid); pg8::gemm_phase<EpiResid, pg8::StaticOrder>(ldsl, g, S, E, nullptr);
        SkArgs a{}; a.A = g.A + (size_t)16384 * g.K; a.Bt = g.Bt; a.K = g.K; a.N = 1024; a.An = An; a.mod = mod; a.nw = E.nw; a.pw = E.pw; a.goff = E.goff; a.soff = E.soff; a.poff = E.poff; a.coef = E.coef; skinny_phase<1, 2>(p, a, 1, lds); }
    else if constexpr (KIND == 6) { const int t0 = layer * 60 + 22; pg8::Gemm g{An, W1 + (size_t)t0 * 256 * 1024, 16384, 4096, 1024}; pg8::StaticOrder S; S.init(16384, 4096, G, cid);
        SkArgs a{}; a.A = An + (size_t)16384 * 1024; a.Bt = g.Bt; a.K = 1024; a.N = 4096; a.cb = cb + (size_t)t0 * 256; a.O = PROJ; skinny_phase<2, 8>(p, a, 2, lds);
        EpiProj<0> E{PROJ, ssq, cb + (size_t)t0 * 256, nullptr}; pg8::gemm_phase<EpiProj<0>, pg8::StaticOrder>(ldsl, g, S, E, nullptr); }
    else if constexpr (KIND == 12) { const int t0 = layer * 60 + 22; pg8::Gemm g{An, W1 + (size_t)t0 * 256 * 1024, 16384, 4096, 1024}; pg8::StaticOrder S; S.init(16384, 4096, G, cid);
        SkArgs a{}; a.A = An + (size_t)16384 * 1024; a.Bt = g.Bt; a.K = 1024; a.N = 4096; a.cb = cb + (size_t)t0 * 256; a.O = PROJ; skinny_phase<3, 8>(p, a, 2, lds);
        EpiProj<1> E{PROJ, ssq, cb + (size_t)t0 * 256, (float*)(ws + OFF_LNP)}; pg8::gemm_phase<EpiProj<1>, pg8::StaticOrder>(ldsl, g, S, E, nullptr); }
    else if constexpr (KIND == 7) { prep_phase(p, li, lds); }
    else if constexpr (KIND == 8) { if (G <= 64) { for (int bh = cid; bh < 64; bh += G) scan_block(p, li, bh, lds); for (int it = cid; it < 1024; it += G) sampleA_item(p, li, it >> 3, it & 7, lds); }
        else if (cid < 64) scan_block(p, li, cid, lds);
        else for (int it = cid - 64; it < 1024; it += G - 64) sampleA_item(p, li, it >> 3, it & 7, lds); }
    else if constexpr (KIND == 9) { mixB_phase(p, li, lds); }
    else if constexpr (KIND == 11) { phase_final(p); }
}
__device__ __forceinline__ void run_phase(const Params& p, int ph, unsigned char* lds, bool dummy = false) {
    int kind, layer, f; decode_phase(ph, kind, layer, f);
    if (kind == 6 && (layer & 1)) kind = 12;
#ifdef MK_PROBE_DUMMY
    if (kind == 4 && dummy) kind = 13;
#endif
    switch (kind) {
        case 0: run_kind<0>(p, layer, f, lds); break; case 1: run_kind<1>(p, layer, f, lds); break; case 2: run_kind<2>(p, layer, f, lds); break; case 3: run_kind<3>(p, layer, f, lds); break;
        case 4: run_kind<4>(p, layer, f, lds); break; case 5: run_kind<5>(p, layer, f, lds); break; case 6: run_kind<6>(p, layer, f, lds); break; case 7: run_kind<7>(p, layer, f, lds); break;
        case 8: run_kind<8>(p, layer, f, lds); break; case 9: run_kind<9>(p, layer, f, lds); break; case 10: run_kind<10>(p, layer, f, lds); break; case 11: run_kind<11>(p, layer, f, lds); break;
        case 12: run_kind<12>(p, layer, f, lds); break;
#ifdef MK_PROBE_DUMMY
        case 13: run_kind<13>(p, layer, f, lds); break;
#endif
        default: break; }
}
#if MK_MULTI
template <int KIND> __global__ void __launch_bounds__(512, 2) mk_kind(Params p, int layer, int f) {
    extern __shared__ __attribute__((aligned(16))) unsigned char lds[];
    run_kind<KIND>(p, layer, f, lds);
}
#else
__global__ void __launch_bounds__(512, 2) mk_fwd(Params p) {
    extern __shared__ __attribute__((aligned(16))) unsigned char lds[];
    cg::grid_group grid = cg::this_grid();
    volatile LAS unsigned* xst = (volatile LAS unsigned*)(lds + LDS_BYTES - 16);
    if (threadIdx.x == 0) { xst[0] = 0u; xst[1] = 0u; }
    __syncthreads();
    const XcdBarrier xb = xcd_barrier_post((unsigned*)(p.ws + OFF_BAR), xst);
#ifdef MK_REPEAT_KIND
    for (int it_ = 2 * p.ph_lo; it_ < 2 * p.ph_hi; ++it_) { const int ph = it_ >> 1;
        { int kind_, layer_, f_; decode_phase(ph, kind_, layer_, f_); if ((it_ & 1) == 0 && kind_ != MK_REPEAT_KIND) continue; }
#else
    for (int ph = p.ph_lo; ph < p.ph_hi; ++ph) {
#endif
        Params q = p;
        long long z_ = 0; asm volatile("" : "+s"(z_));
#define LND(m) q.m = (decltype(q.m))((const unsigned char*)p.m + z_);
        LND(x_prompt) LND(x_sample) LND(st_conv) LND(st_S) LND(c_prompt) LND(c_sample) LND(w_ada) LND(b_ada) LND(norm_w) LND(w_gu) LND(w_down) LND(a_w_in) LND(a_w_conv) LND(a_log) LND(a_dt_bias)
        LND(a_w_onorm) LND(a_w_out) LND(b_w_in) LND(b_vnorm_w) LND(b_vnorm_b) LND(b_w_s) LND(b_b_s) LND(b_w_out) LND(final_w)
        q.out = (float*)((unsigned char*)p.out + z_); q.ws = p.ws + z_;
#undef LND
#if defined(MK_REPEAT_KIND) && defined(MK_PROBE_DUMMY)
        run_phase(q, ph, lds, (it_ & 1) == 0);
#else
        run_phase(q, ph, lds);
#endif
        if (ph + 1 < p.ph_hi) {
            if (MK_COOP && p.ph_hi < 0) { __syncthreads(); grid.sync(); }
            xcd_barrier(xb);
        }
    }
}
#endif

#if MK_MULTI
template <int KIND> static void launch_kind(const Params& p, int layer, int f, int grid, hipStream_t stream) {
    static bool attr = false;
    if (!attr) { (void)hipFuncSetAttribute((const void*)mk_kind<KIND>, hipFuncAttributeMaxDynamicSharedMemorySize, LDS_BYTES); attr = true; }
    hipLaunchKernelGGL(mk_kind<KIND>, dim3(grid), dim3(512), LDS_BYTES, stream, p, layer, f);
}
#endif
extern "C" void kernel_launch(void* const* d_in, const int* in_sizes, int n_in, void* d_out, int out_size, void* d_ws, size_t ws_size, hipStream_t stream) {
    static int grid = 0;
    if (grid == 0) {
        if (n_in != 24 || ws_size < WS_NEED) { fprintf(stderr, "kernel_launch: n_in %d ws %zu need %zu\n", n_in, ws_size, (size_t)WS_NEED); grid = -1; return; }
        int dev = 0, cus = 0;
        (void)hipGetDevice(&dev); (void)hipDeviceGetAttribute(&cus, hipDeviceAttributeMultiprocessorCount, dev);
#if !MK_MULTI
        int per_cu = 0;
        if (hipFuncSetAttribute((const void*)mk_fwd, hipFuncAttributeMaxDynamicSharedMemorySize, LDS_BYTES) != hipSuccess) { fprintf(stderr, "kernel_launch: hipFuncSetAttribute failed\n"); grid = -1; return; }
        (void)hipOccupancyMaxActiveBlocksPerMultiprocessor(&per_cu, (const void*)mk_fwd, 512, LDS_BYTES);
        (void)hipGetLastError();
        if (per_cu < 1) fprintf(stderr, "kernel_launch: occupancy query says %d\n", per_cu);
#endif
        grid = cus;
    }
    if (grid < 0) return;
    Params p{};
    const float** pp = (const float**)&p;
    for (int i = 0; i < 24; ++i) pp[i] = (const float*)d_in[i];
    p.out = (float*)d_out; p.ws = (unsigned char*)d_ws;
#if MK_MULTI
    for (int ph = 0; ph < NPHASE; ++ph) { int kind, layer, f; decode_phase(ph, kind, layer, f); if (kind == 6 && (layer & 1)) kind = 12;
        switch (kind) {
            case 0: launch_kind<0>(p, layer, f, grid, stream); break; case 1: launch_kind<1>(p, layer, f, grid, stream); break; case 2: launch_kind<2>(p, layer, f, grid, stream); break;
            case 3: launch_kind<3>(p, layer, f, grid, stream); break; case 4: launch_kind<4>(p, layer, f, grid, stream); break; case 5: launch_kind<5>(p, layer, f, grid, stream); break;
            case 6: launch_kind<6>(p, layer, f, grid, stream); break; case 7: launch_kind<7>(p, layer, f, grid, stream); break; case 8: launch_kind<8>(p, layer, f, grid, stream); break;
            case 9: launch_kind<9>(p, layer, f, grid, stream); break; case 10: launch_kind<10>(p, layer, f, grid, stream); break; case 11: launch_kind<11>(p, layer, f, grid, stream); break;
            case 12: launch_kind<12>(p, layer, f, grid, stream); break; default: break; } }
#else
    p.ph_lo = 0; p.ph_hi = NPHASE;
    (void)hipMemsetAsync((unsigned char*)d_ws + OFF_BAR, 0, XCD_BAR_WORDS * 4, stream);
    void* args[] = {&p};
#if MK_COOP
    hipError_t e = hipLaunchCooperativeKernel((const void*)mk_fwd, dim3(grid), dim3(512), args, LDS_BYTES, stream);
#else
    hipError_t e = hipLaunchKernel((const void*)mk_fwd, dim3(grid), dim3(512), args, LDS_BYTES, stream);
#endif
    if (e != hipSuccess) fprintf(stderr, "cooperative launch failed: %s (grid %d)\n", hipGetErrorString(e), grid);
#endif
}
```

```cpp
#include <hip/hip_runtime.h>
#include <hip/hip_cooperative_groups.h>
#include <cstdio>
namespace cg = cooperative_groups;
#ifndef MK_MULTI
#define MK_MULTI 0
#endif
#ifndef MK_COOP
#define MK_COOP 1
#endif
namespace pg8 {
#define PG8_LAS __attribute__((address_space(3)))
typedef unsigned short bf16_t;
typedef short bf16x8 __attribute__((ext_vector_type(8)));
typedef float f32x4 __attribute__((ext_vector_type(4)));
typedef unsigned u32x4 __attribute__((ext_vector_type(4)));
constexpr int BM = 256, BK = 64, HALF = 128, HTB = HALF * BK * 2  , STAGE_BYTES = 8 * HTB, NXCD = 8, WGM = 8;

__host__ __device__ __forceinline__ int lds_byte(int r, int c) { const int st = (r >> 4) * 2 + (c >> 5), rr = r & 15, cc = c & 31, ob = rr * 64 + cc * 2; return st * 1024 + (ob ^ (((ob >> 9) & 1) << 5)); }
__host__ __device__ __forceinline__ void stage_rc(int b, int& R, int& C) { const int st = b / 1024, sb = b % 1024, swz = sb ^ (((sb >> 9) & 1) << 5); R = (st >> 1) * 16 + swz / 64; C = (st & 1) * 32 + (swz % 64) / 2; }
__host__ __device__ __forceinline__ int perm32(int rho) { const int n = rho >> 4, i = rho & 15; return 8 * (i >> 2) + 4 * n + (i & 3); }

struct Unit { int pm, pn; };
struct Gemm { const bf16_t* A; const bf16_t* Bt; int M, N, K; };

struct StaticOrder {
    int nM, nN, nwg, G, c;
    __host__ __device__ void init(int M, int N, int G_, int c_) { nM = M / BM; nN = N / BM; nwg = nM * nN; G = G_; c = c_; }
    __host__ __device__ bool next(int i, Unit& u) const {
        const long L = (long)i * G + c; if (L >= nwg) return false;
        int wgid = (int)L; { const int q = nwg / NXCD, r = nwg % NXCD, xcd = wgid % NXCD, off = wgid / NXCD; wgid = (xcd < r ? xcd * (q + 1) : r * (q + 1) + (xcd - r) * q) + off; }
        const int nig = WGM * nN, gid = wgid / nig, fm = gid * WGM, gsz = (nM - fm) < WGM ? (nM - fm) : WGM;
        u.pm = fm + ((wgid % nig) % gsz); u.pn = (wgid % nig) / gsz; return true;
    }
    __device__ __forceinline__ void a_ready(const Unit&) const {}
    __device__ __forceinline__ void done(const Unit&) const {}
};
__device__ __forceinline__ unsigned cvt_pk_bf16(float lo, float hi) { unsigned r; asm volatile("v_cvt_pk_bf16_f32 %0, %1, %2" : "=v"(r) : "v"(lo), "v"(hi)); return r; }
typedef float f32x2 __attribute__((ext_vector_type(2)));
template <class Epi, class Sched, bool STAMP = false>
__device__ __forceinline__ void gemm_phase(PG8_LAS unsigned char* lds, const Gemm g, const Sched& S, const Epi& E, unsigned long long* stamps) {
    int tid_l = threadIdx.x; asm volatile("" : "+v"(tid_l)); const int tid = tid_l, wid = __builtin_amdgcn_readfirstlane(tid >> 6), lane = tid & 63, wr = wid >> 2, wc = wid & 3, fr = lane & 15, fq = lane >> 4;
    const int K = g.K, nt = K / BK;
    int ts_lo = 0, ts_hi = 0, nts = 0; const unsigned long long rt_entry = STAMP ? (unsigned long long)wall_clock64() : 0ull;
#define PG8_STAMP() do { if (STAMP && wid == 0 && nts < 64) { const unsigned long long _c = (unsigned long long)clock64(); \
        ts_lo = (lane == nts) ? (int)(unsigned)_c : ts_lo; ts_hi = (lane == nts) ? (int)(unsigned)(_c >> 32) : ts_hi; ++nts; } } while (0)
    PG8_STAMP();
    unsigned voffA[2], voffB[2];
#pragma unroll
    for (int i = 0; i < 2; ++i) { int R, C; stage_rc(tid * 16 + i * 8192, R, C); const int Rb = Epi::PERM ? ((R & ~31) + perm32(R & 31)) : R;
        voffA[i] = (unsigned)(R * K + C) * 2u; voffB[i] = (unsigned)(Rb * K + C) * 2u; }
    const size_t kstep = (size_t)(BK * 2);
    const size_t hstep = (size_t)HALF * K * 2;
    const size_t tstep = 2 * hstep;
    const unsigned ldsw = (unsigned)wid * 1024u;
    const int aoff = lds_byte(wr * 64 + fr, fq * 8), boff = lds_byte(wc * 32 + fr, fq * 8);
#define PG8_SA(b, h) (((b) * 2 + (h)) * HTB)
#define PG8_SB(b, h) ((4 + (b) * 2 + (h)) * HTB)
#define PG8_STAGE(bufoff, gbase, voff) do { _Pragma("unroll") for (int _i = 0; _i < 2; ++_i) \
        __builtin_amdgcn_global_load_lds((const unsigned*)((const char*)(gbase) + (voff)[_i]), (PG8_LAS unsigned*)(lds + (bufoff) + ldsw + _i * 8192), 16, 0, 0); } while (0)
#define PG8_LDA(dst, b, h) do { _Pragma("unroll") for (int m = 0; m < 4; ++m) _Pragma("unroll") for (int k = 0; k < 2; ++k) dst[m][k] = *(const PG8_LAS bf16x8*)(lds + PG8_SA(b, h) + aoff + m * 2048 + k * 1024); } while (0)
#define PG8_LDB(dst, b, h) do { _Pragma("unroll") for (int n = 0; n < 2; ++n) _Pragma("unroll") for (int k = 0; k < 2; ++k) dst[n][k] = *(const PG8_LAS bf16x8*)(lds + PG8_SB(b, h) + boff + n * 2048 + k * 1024); } while (0)
#define PG8_MMA(ai, bj, At, Bt) do { __builtin_amdgcn_s_setprio(1); _Pragma("unroll") for (int m = 0; m < 4; ++m) _Pragma("unroll") for (int n = 0; n < 2; ++n) _Pragma("unroll") for (int k = 0; k < 2; ++k) \
        acc[ai][bj][m][n] = __builtin_amdgcn_mfma_f32_16x16x32_bf16(Bt[n][k], At[m][k], acc[ai][bj][m][n], 0, 0, 0); __builtin_amdgcn_s_setprio(0); } while (0)
#define PG8_WAIT_V(n) asm volatile("s_waitcnt vmcnt(" #n ")" ::: "memory")
#define PG8_WAIT_L(n) asm volatile("s_waitcnt lgkmcnt(" #n ")" ::: "memory")
#define PG8_BAR __builtin_amdgcn_s_barrier()
#define PG8_SCHED __builtin_amdgcn_sched_barrier(0)
    Unit cur, nxt; int ui = 0;
    if (!S.next(0, cur)) return;
    f32x4 acc[2][2][4][2];
#pragma unroll
    for (int a = 0; a < 2; ++a)
#pragma unroll
        for (int b = 0; b < 2; ++b)
#pragma unroll
            for (int m = 0; m < 4; ++m)
#pragma unroll
                for (int n = 0; n < 2; ++n) acc[a][b][m][n] = (f32x4){0.f, 0.f, 0.f, 0.f};
    bf16x8 At[4][2], B0[2][2], B1[2][2];
    const char* cA = (const char*)g.A + (size_t)cur.pm * tstep; const char* cB = (const char*)g.Bt + (size_t)cur.pn * tstep;
    S.a_ready(cur);
    PG8_STAGE(PG8_SB(0, 0), cB, voffB); PG8_STAGE(PG8_SA(0, 0), cA, voffA); PG8_STAGE(PG8_SB(0, 1), cB + hstep, voffB); PG8_STAGE(PG8_SA(0, 1), cA + hstep, voffA);
    if (wr == 1) PG8_BAR;
    PG8_WAIT_V(4); PG8_BAR;
    PG8_STAGE(PG8_SB(1, 0), cB + kstep, voffB); PG8_STAGE(PG8_SA(1, 0), cA + kstep, voffA); PG8_STAGE(PG8_SB(1, 1), cB + hstep + kstep, voffB);
    PG8_WAIT_V(6); PG8_BAR;
    PG8_STAMP();
    for (;;) {
        const bool has_next = S.next(ui + 1, nxt);
        const char* nA = has_next ? (const char*)g.A + (size_t)nxt.pm * tstep : cA; const char* nB = has_next ? (const char*)g.Bt + (size_t)nxt.pn * tstep : cB;
        for (int t = 0; t < nt; t += 2) {
            const bool last = (t == nt - 2);
            const char* a1 = cA + (size_t)(t + 1) * kstep;
            const char* a2 = last ? nA : cA + (size_t)(t + 2) * kstep; const char* b2 = last ? nB : cB + (size_t)(t + 2) * kstep;
            const char* a3 = a2 + kstep; const char* b3 = b2 + kstep;
            if (last && has_next) S.a_ready(nxt);
            PG8_LDB(B0, 0, 0); PG8_SCHED; PG8_LDA(At, 0, 0); PG8_STAGE(PG8_SA(1, 1), a1 + hstep, voffA);
            PG8_WAIT_L(8); PG8_BAR; PG8_WAIT_L(0); PG8_MMA(0, 0, At, B0); PG8_BAR; PG8_SCHED;
            PG8_LDB(B1, 0, 1); PG8_STAGE(PG8_SB(0, 0), b2, voffB);
            PG8_BAR; PG8_WAIT_L(0); PG8_MMA(0, 1, At, B1); PG8_BAR;
            PG8_LDA(At, 0, 1); PG8_STAGE(PG8_SA(0, 0), a2, voffA);
            PG8_BAR; PG8_WAIT_L(0); PG8_MMA(1, 0, At, B0); PG8_BAR; PG8_SCHED;
            PG8_STAGE(PG8_SB(0, 1), b2 + hstep, voffB);
            PG8_WAIT_V(6); PG8_BAR; PG8_MMA(1, 1, At, B1); PG8_BAR;
            PG8_LDB(B0, 1, 0); PG8_SCHED; PG8_LDA(At, 1, 0); PG8_STAGE(PG8_SA(0, 1), a2 + hstep, voffA);
            PG8_WAIT_L(8); PG8_BAR; PG8_WAIT_L(0); PG8_MMA(0, 0, At, B0); PG8_BAR; PG8_SCHED;
            PG8_LDB(B1, 1, 1); PG8_STAGE(PG8_SB(1, 0), b3, voffB);
            PG8_BAR; PG8_WAIT_L(0); PG8_MMA(0, 1, At, B1); PG8_BAR;
            PG8_LDA(At, 1, 1); PG8_STAGE(PG8_SA(1, 0), a3, voffA);
            PG8_BAR; PG8_WAIT_L(0); PG8_MMA(1, 0, At, B0); PG8_BAR; PG8_SCHED;
            PG8_STAGE(PG8_SB(1, 1), b3 + hstep, voffB);
            PG8_WAIT_V(6); PG8_BAR; PG8_MMA(1, 1, At, B1); PG8_BAR;
        }
        PG8_STAMP();
        if constexpr (!Epi::AFTER_DRAIN) { E(acc, cur, wr, wc, fr, fq); S.done(cur); }
        PG8_STAMP();
        if (!has_next) break;
#pragma unroll
        for (int a = 0; a < 2; ++a)
#pragma unroll
            for (int b = 0; b < 2; ++b)
#pragma unroll
                for (int m = 0; m < 4; ++m)
#pragma unroll
                    for (int n = 0; n < 2; ++n) acc[a][b][m][n] = (f32x4){0.f, 0.f, 0.f, 0.f};
        cur = nxt; cA = nA; cB = nB; ++ui;
    }
    PG8_WAIT_V(0);
    if (wr == 0) PG8_BAR;
    PG8_BAR;
    if constexpr (Epi::AFTER_DRAIN) { E.fused(acc, cur, wr, wc, fr, fq, lds, wid, lane); S.done(cur); }
    PG8_STAMP();
    if (STAMP && wid == 0) { stamps[lane] = lane < nts ? (((unsigned long long)(unsigned)ts_hi << 32) | (unsigned)ts_lo) : 0ull;
        if (lane == 62) stamps[62] = rt_entry; if (lane == 63) stamps[63] = (unsigned long long)wall_clock64(); }
#undef PG8_STAMP
#undef PG8_SA
#undef PG8_SB
#undef PG8_STAGE
#undef PG8_LDA
#undef PG8_LDB
#undef PG8_MMA
#undef PG8_WAIT_V
#undef PG8_WAIT_L
#undef PG8_BAR
#undef PG8_SCHED
}
}
#define XB_TMO      128
#define XB_XCNT(j)  (256  + 64 * (j))
#define XB_XSUB(j)  (1280 + 64 * (j))
#define XB_XGEN(j)  (2304 + 64 * (j))
#define XB_TOP      3328
#define XB_TOPGEN   3392
#define XCD_BAR_WORDS 3456
#define XB_SPIN_CAP (1u << 18)
#define LAS __attribute__((address_space(3)))

__device__ __forceinline__ unsigned xb_ld(unsigned* p)              { return __hip_atomic_load(p, __ATOMIC_RELAXED, __HIP_MEMORY_SCOPE_AGENT); }
__device__ __forceinline__ unsigned xb_add(unsigned* p, unsigned v) { return __hip_atomic_fetch_add(p, v, __ATOMIC_RELAXED, __HIP_MEMORY_SCOPE_AGENT); }
__device__ __forceinline__ unsigned xb_xcc_id() { return (unsigned)__builtin_amdgcn_s_getreg((3 << 11) | 20) & 0xFu; }
#define XB_SPIN(cond, bar) do { unsigned _sp = 0; while (cond) { __builtin_amdgcn_s_sleep(1); \
    if ((++_sp & 255u) == 0u) { if (xb_ld(&(bar)[XB_TMO])) break; if (_sp > XB_SPIN_CAP) { atomicAdd(&(bar)[XB_TMO], 1u); break; } } } } while (0)

struct XcdBarrier {
    unsigned* bar; unsigned x;
    volatile LAS unsigned* st;
};

__device__ __forceinline__ XcdBarrier xcd_barrier_post(unsigned* bar, volatile LAS unsigned* st) {
    XcdBarrier b; b.bar = bar; b.x = xb_xcc_id(); b.st = st;
    if (threadIdx.x == 0) (void)xb_add(&bar[XB_XCNT(b.x)], 1u);
    return b;
}
__device__ __forceinline__ void xcd_barrier_complete(unsigned* bar, unsigned x, unsigned& nloc, unsigned& nx) {
    const unsigned G = gridDim.x * gridDim.y * gridDim.z;
    unsigned sum, cnt, mine, sp = 0u;
    for (;;) {
        sum = 0u; cnt = 0u; mine = 0u;
#pragma unroll
        for (unsigned j = 0; j < 16; ++j) { const unsigned c = xb_ld(&bar[XB_XCNT(j)]); sum += c; cnt += (c > 0u) ? 1u : 0u; mine = (j == x) ? c : mine; }
        if (sum == G) break;
        __builtin_amdgcn_s_sleep(1);
        if ((++sp & 255u) == 0u) { if (xb_ld(&bar[XB_TMO])) break; if (sp > XB_SPIN_CAP) { atomicAdd(&bar[XB_TMO], 1u); break; } }
    }
    nloc = mine > 0u ? mine : 1u; nx = cnt > 0u ? cnt : 1u;
}

__device__ __forceinline__ void xcd_barrier(const XcdBarrier& b) {
    asm volatile("s_waitcnt vmcnt(0)" ::: "memory");
    __syncthreads();
    if (threadIdx.x == 0) {
        unsigned* bar = b.bar;
        __builtin_amdgcn_s_waitcnt(0);
        unsigned nloc = b.st[0], nx = b.st[1];
        if (nloc == 0u) { xcd_barrier_complete(bar, b.x, nloc, nx); b.st[0] = nloc; b.st[1] = nx; }
        const unsigned old = xb_add(&bar[XB_XSUB(b.x)], 1u);
        const unsigned gen = old / nloc;
        if (old + 1u == (gen + 1u) * nloc) {
            __builtin_amdgcn_fence(__ATOMIC_RELEASE, "agent");
            asm volatile("s_waitcnt vmcnt(0)" ::: "memory");
            const unsigned og = xb_add(&bar[XB_TOP], 1u);
            const unsigned tg = og / nx;
            if (og + 1u == (tg + 1u) * nx) xb_add(&bar[XB_TOPGEN], 1u);
            else XB_SPIN(xb_ld(&bar[XB_TOPGEN]) == tg, bar);
            __builtin_amdgcn_fence(__ATOMIC_ACQUIRE, "agent");
            xb_add(&bar[XB_XGEN(b.x)], 1u);
            asm volatile("s_waitcnt vmcnt(0)" ::: "memory");
        } else {
            XB_SPIN(xb_ld(&bar[XB_XGEN(b.x)]) == gen, bar);
            __builtin_amdgcn_fence(__ATOMIC_ACQUIRE, "agent");
            asm volatile("s_waitcnt vmcnt(0)" ::: "memory");
        }
    }
    __syncthreads();
}

using pg8::bf16_t; using pg8::bf16x8; using pg8::f32x4; using pg8::Unit; using pg8::cvt_pk_bf16;
typedef unsigned u32x2 __attribute__((ext_vector_type(2)));
typedef unsigned u32x4 __attribute__((ext_vector_type(4)));
constexpr int MPAD = 16640, MODLD = 36864, CBLD = 61440, LDS_BYTES = 143360, NPHASE = 35;
constexpr size_t ITEM_BYTES = 73792;
constexpr size_t OFF_W1 = 0, SZ_W1 = (size_t)4 * 60 * 256 * 1024 * 2;
constexpr size_t OFF_WDN = OFF_W1 + SZ_W1, SZ_WDN = (size_t)8 * 1024 * 2816 * 2;
constexpr size_t OFF_WOA = OFF_WDN + SZ_WDN, SZ_WOA = (size_t)2 * 1024 * 1024 * 2;
constexpr size_t OFF_WOB = OFF_WOA + SZ_WOA, SZ_WOB = (size_t)2 * 1024 * 2048 * 2;
constexpr size_t OFF_MOD = OFF_WOB + SZ_WOB, SZ_MOD = (size_t)136 * MODLD * 4;
constexpr size_t OFF_CB = OFF_MOD + SZ_MOD, SZ_CB = (size_t)136 * CBLD * 4;
constexpr size_t OFF_SH = OFF_CB + SZ_CB, SZ_SH = (size_t)12 * 256 * 1024 * 2;
constexpr size_t OFF_SC = OFF_SH + SZ_SH, SZ_SC = (size_t)256 * 1024 * 2;
constexpr size_t OFF_WLOG = OFF_SC + SZ_SC, SZ_WLOG = (size_t)2 * 16 * 1024 * 4;
constexpr size_t OFF_CB16 = OFF_WLOG + SZ_WLOG, SZ_CB16 = (size_t)2 * 136 * 16 * 4 + 16384 + 16384 + 65536;
constexpr size_t OFF_BAR = OFF_CB16 + (size_t)2 * 136 * 16 * 4;
constexpr size_t OFF_SSQS = OFF_BAR + 16384;
constexpr size_t OFF_LNPS = OFF_SSQS + 16384;
constexpr size_t OFF_X = OFF_CB16 + SZ_CB16, SZ_X = (size_t)MPAD * 1024 * 4;
constexpr size_t OFF_AN = OFF_X + SZ_X, SZ_AN = (size_t)MPAD * 1024 * 2;
constexpr size_t OFF_SSQ = OFF_AN + SZ_AN, SZ_SSQ = (size_t)MPAD * 16 * 4;
constexpr size_t OFF_LNP = OFF_SSQ + SZ_SSQ, SZ_LNP = (size_t)MPAD * 64 * 4;
constexpr size_t OFF_PROJ = OFF_LNP + SZ_LNP, SZ_PROJ = (size_t)MPAD * 4096 * 2;
constexpr size_t OFF_OAB = OFF_PROJ + SZ_PROJ, SZ_OAB = (size_t)MPAD * 2048 * 2;
constexpr size_t OFF_R1 = OFF_OAB + SZ_OAB, SZ_R1 = (size_t)2048 * ITEM_BYTES;
constexpr size_t WS_NEED = OFF_R1 + SZ_R1;
static_assert(SZ_R1 >= (size_t)MPAD * 2816 * 2 && SZ_R1 >= (size_t)36864 * 1024 * 2, "R1");
static_assert(OFF_X % 256 == 0 && OFF_R1 % 256 == 0 && OFF_PROJ % 256 == 0, "align");
constexpr size_t OUT_Y = 0, OUT_CONVP = (size_t)16512 * 1024, OUT_SP = OUT_CONVP + 2 * 8 * 3 * 3072, OUT_CONVS = OUT_SP + (size_t)2 * 8 * 8 * 128 * 128,
                 OUT_SS = OUT_CONVS + (size_t)2 * 128 * 3 * 3072, OUT_VS = OUT_SS + (size_t)2 * 128 * 8 * 128 * 128;

struct Params {
    const float *x_prompt, *x_sample, *st_conv, *st_S, *c_prompt, *c_sample, *w_ada, *b_ada, *norm_w, *w_gu, *w_down, *a_w_in, *a_w_conv, *a_log, *a_dt_bias,
        *a_w_onorm, *a_w_out, *b_w_in, *b_vnorm_w, *b_vnorm_b, *b_w_s, *b_b_s, *b_w_out, *final_w;
    float* out; unsigned char* ws; int ph_lo, ph_hi;
};

__device__ __forceinline__ int tidx() { int t = threadIdx.x; asm volatile("" : "+v"(t)); return t; }
__device__ __forceinline__ float bf2f(bf16_t b) { return __uint_as_float(((unsigned)b) << 16); }
__device__ __forceinline__ bf16_t f2bf(float f) { return (bf16_t)(cvt_pk_bf16(f, 0.f) & 0xffffu); }
__device__ __forceinline__ float wsum(float v) {
#pragma unroll
    for (int o = 32; o >= 1; o >>= 1) v += __shfl_xor(v, o);
    return v; }
__device__ __forceinline__ void lds_barrier() { asm volatile("s_waitcnt lgkmcnt(0)\n\ts_barrier" ::: "memory"); }
template <int CTRL> __device__ __forceinline__ float dppf(float v) { return __builtin_bit_cast(float, __builtin_amdgcn_update_dpp(0, __builtin_bit_cast(int, v), CTRL, 0xF, 0xF, false)); }
__device__ __forceinline__ float row16_sum(float v) {
    v += dppf<0xB1>(v); v += dppf<0x4E>(v); v += dppf<0x141>(v); v += dppf<0x140>(v); return v; }
__device__ __forceinline__ float sigmoidf_(float x) { return __builtin_amdgcn_rcpf(1.0f + __expf(-x)); }
__device__ __forceinline__ float siluf_(float x) { return x * sigmoidf_(x); }
__device__ __forceinline__ float gelu_tanh(float x) { const float u2 = 1.5957691216f * (x + 0.044715f * x * x * x); return x * sigmoidf_(u2); }
__device__ __forceinline__ int row_b(int row) { return row < 16384 ? (row >> 11) : min(row - 16384 + 8, 135); }
__device__ __forceinline__ float row_rstd(const float* ssq, int row) {
    const f32x4* q = (const f32x4*)(ssq + (size_t)row * 16); const f32x4 a = q[0], b = q[1], c = q[2], d = q[3];
    const float s = ((a[0] + a[1]) + (a[2] + a[3])) + ((b[0] + b[1]) + (b[2] + b[3])) + ((c[0] + c[1]) + (c[2] + c[3])) + ((d[0] + d[1]) + (d[2] + d[3]));
    return rsqrtf(s * (1.0f / 1024.0f) + 1e-6f); }
__device__ __forceinline__ float srow_rstd(const float* ssqS, int r) { const f32x4* q = (const f32x4*)(ssqS + r * 32); float s = 0.f;
#pragma unroll
    for (int j = 0; j < 8; ++j) { const f32x4 a = q[j]; s += (a[0] + a[1]) + (a[2] + a[3]); }
    return rsqrtf(s * (1.0f / 1024.0f) + 1e-6f); }
__device__ __forceinline__ float row_rstd4(const float* ssq, int row, int fq) {
    const f32x4 a = *(const f32x4*)(ssq + (size_t)row * 16 + 4 * fq); float s = (a[0] + a[1]) + (a[2] + a[3]); s += __shfl_xor(s, 16); s += __shfl_xor(s, 32);
    return rsqrtf(s * (1.0f / 1024.0f) + 1e-6f); }
__device__ __forceinline__ u32x2 pack4(f32x4 v) { u32x2 r; r.x = cvt_pk_bf16(v[0], v[1]); r.y = cvt_pk_bf16(v[2], v[3]); return r; }
__device__ __forceinline__ bf16x8 pack8(f32x4 a, f32x4 b) { u32x4 r; r.x = cvt_pk_bf16(a[0], a[1]); r.y = cvt_pk_bf16(a[2], a[3]); r.z = cvt_pk_bf16(b[0], b[1]); r.w = cvt_pk_bf16(b[2], b[3]);
    return __builtin_bit_cast(bf16x8, r); }
__device__ __forceinline__ f32x4 unpack4(u32x2 w) { f32x4 r; r[0] = __uint_as_float(w.x << 16); r[1] = __uint_as_float(w.x & 0xffff0000u); r[2] = __uint_as_float(w.y << 16); r[3] = __uint_as_float(w.y & 0xffff0000u); return r; }

struct EpiMod {
    static constexpr bool PERM = false, AFTER_DRAIN = false;
    float* C; const float* bias;
    __device__ __forceinline__ void operator()(const f32x4 (&acc)[2][2][4][2], const Unit& u, int wr, int wc, int fr, int fq) const {
#pragma unroll
        for (int ai = 0; ai < 2; ++ai)
#pragma unroll
            for (int m = 0; m < 4; ++m) { const int r = ai * 128 + wr * 64 + m * 16 + fr; if (r < 136) {
#pragma unroll
                for (int bj = 0; bj < 2; ++bj)
#pragma unroll
                    for (int n = 0; n < 2; ++n) { const int c = u.pn * 256 + bj * 128 + wc * 32 + n * 16 + 4 * fq;
                        *(f32x4*)(C + (size_t)r * MODLD + c) = acc[ai][bj][m][n] + *(const f32x4*)(bias + c); } } }
    }
};
struct EpiCb {
    static constexpr bool PERM = false, AFTER_DRAIN = false;
    float* C;
    __device__ __forceinline__ void operator()(const f32x4 (&acc)[2][2][4][2], const Unit& u, int wr, int wc, int fr, int fq) const {
#pragma unroll
        for (int ai = 0; ai < 2; ++ai)
#pragma unroll
            for (int m = 0; m < 4; ++m) { const int r = ai * 128 + wr * 64 + m * 16 + fr; if (r < 136) {
#pragma unroll
                for (int bj = 0; bj < 2; ++bj)
#pragma unroll
                    for (int n = 0; n < 2; ++n) { const int c = u.pn * 256 + bj * 128 + wc * 32 + n * 16 + 4 * fq;
                        *(f32x4*)(C + (size_t)r * CBLD + c) = acc[ai][bj][m][n]; } } }
    }
};
struct CbOrder {
    int G, c;
    __device__ bool next(int i, Unit& u) const { const int L = i * G + c; if (L >= 240) return false; const int layer = L / 60, rem = L % 60; u.pm = layer * 3 + (rem < 22 ? 0 : (rem < 38 ? 1 : 2)); u.pn = L; return true; }
    __device__ __forceinline__ void a_ready(const Unit&) const {}
    __device__ __forceinline__ void done(const Unit&) const {}
};
struct EpiDummy {
    static constexpr bool PERM = true, AFTER_DRAIN = false;
    bf16_t* O;
    __device__ __forceinline__ void operator()(const f32x4 (&acc)[2][2][4][2], const Unit& u, int wr, int wc, int fr, int fq) const {
#pragma unroll
        for (int ai = 0; ai < 2; ++ai)
#pragma unroll
            for (int m = 0; m < 4; ++m) { const int row = u.pm * 256 + ai * 128 + wr * 64 + m * 16 + fr;
#pragma unroll
                for (int bj = 0; bj < 2; ++bj) { u32x4 w; w.x = cvt_pk_bf16(acc[ai][bj][m][0][0], acc[ai][bj][m][0][1]); w.y = cvt_pk_bf16(acc[ai][bj][m][0][2], acc[ai][bj][m][0][3]); w.z = cvt_pk_bf16(acc[ai][bj][m][1][0], acc[ai][bj][m][1][1]); w.w = cvt_pk_bf16(acc[ai][bj][m][1][2], acc[ai][bj][m][1][3]);
                    *(u32x4*)(O + (size_t)row * 4096 + (u.pn % 16) * 256 + bj * 128 + wc * 32 + 8 * fq) = w; } }
    }
};
struct EpiSwiglu {
    static constexpr bool PERM = true, AFTER_DRAIN = false;
    bf16_t* O; const float* ssq; const float* cb;
    __device__ __forceinline__ void operator()(const f32x4 (&acc)[2][2][4][2], const Unit& u, int wr, int wc, int fr, int fq) const {
        const int cl = wc * 32 + 8 * fq; float rs[2][4];
#pragma unroll
        for (int ai = 0; ai < 2; ++ai)
#pragma unroll
            for (int m = 0; m < 4; ++m) rs[ai][m] = row_rstd4(ssq, u.pm * 256 + ai * 128 + wr * 64 + m * 16 + fr, fq);
        if (u.pm < 64) {
            const float* cbr = cb + (size_t)(u.pm >> 3) * CBLD + u.pn * 256 + cl;
            const f32x4 cg0 = *(const f32x4*)(cbr), cg1 = *(const f32x4*)(cbr + 4), cu0 = *(const f32x4*)(cbr + 128), cu1 = *(const f32x4*)(cbr + 132);
#pragma unroll
            for (int ai = 0; ai < 2; ++ai)
#pragma unroll
                for (int m = 0; m < 4; ++m) { const int row = u.pm * 256 + ai * 128 + wr * 64 + m * 16 + fr; const float r_ = rs[ai][m];
                    const f32x4 g0 = acc[ai][0][m][0] * r_ + cg0, g1 = acc[ai][0][m][1] * r_ + cg1, u0 = acc[ai][1][m][0] * r_ + cu0, u1 = acc[ai][1][m][1] * r_ + cu1; f32x4 h0, h1;
#pragma unroll
                    for (int j = 0; j < 4; ++j) { h0[j] = siluf_(g0[j]) * u0[j]; h1[j] = siluf_(g1[j]) * u1[j]; }
                    u32x4 w; w.x = cvt_pk_bf16(h0[0], h0[1]); w.y = cvt_pk_bf16(h0[2], h0[3]); w.z = cvt_pk_bf16(h1[0], h1[1]); w.w = cvt_pk_bf16(h1[2], h1[3]);
                    *(u32x4*)(O + (size_t)row * 2816 + u.pn * 128 + cl) = w; }
        } else {
#pragma unroll
            for (int ai = 0; ai < 2; ++ai)
#pragma unroll
                for (int m = 0; m < 4; ++m) { const int row = u.pm * 256 + ai * 128 + wr * 64 + m * 16 + fr; const int b = row_b(row); const float r_ = rs[ai][m];
                    const float* cbr = cb + (size_t)b * CBLD + u.pn * 256 + cl;
                    const f32x4 g0 = acc[ai][0][m][0] * r_ + *(const f32x4*)(cbr), g1 = acc[ai][0][m][1] * r_ + *(const f32x4*)(cbr + 4);
                    const f32x4 u0 = acc[ai][1][m][0] * r_ + *(const f32x4*)(cbr + 128), u1 = acc[ai][1][m][1] * r_ + *(const f32x4*)(cbr + 132); f32x4 h0, h1;
#pragma unroll
                    for (int j = 0; j < 4; ++j) { h0[j] = siluf_(g0[j]) * u0[j]; h1[j] = siluf_(g1[j]) * u1[j]; }
                    u32x4 w; w.x = cvt_pk_bf16(h0[0], h0[1]); w.y = cvt_pk_bf16(h0[2], h0[3]); w.z = cvt_pk_bf16(h1[0], h1[1]); w.w = cvt_pk_bf16(h1[2], h1[3]);
                    *(u32x4*)(O + (size_t)row * 2816 + u.pn * 128 + cl) = w; }
        }
    }
};
struct EpiResid {
    static constexpr bool PERM = true, AFTER_DRAIN = false;
    bf16_t* An; float* ssq; const float* mod; const float* nw; const float* pw; int goff, soff, poff; float coef;
    __device__ __forceinline__ void operator()(const f32x4 (&acc)[2][2][4][2], const Unit& u, int wr, int wc, int fr, int fq) const {
        const float* modr = mod + (size_t)(u.pm >> 3) * MODLD; float ss[2][4];
#pragma unroll
        for (int ai = 0; ai < 2; ++ai)
#pragma unroll
            for (int m = 0; m < 4; ++m) ss[ai][m] = 0.f;
#pragma unroll
        for (int bj = 0; bj < 2; ++bj) { const int c = u.pn * 256 + bj * 128 + wc * 32 + 8 * fq; f32x4 g[2], a[2], ia[2];
#pragma unroll
            for (int n = 0; n < 2; ++n) { g[n] = (*(const f32x4*)(modr + goff + c + 4 * n) + 1.0f) * coef; a[n] = (f32x4){1.f, 1.f, 1.f, 1.f};
                if (nw) a[n] = *(const f32x4*)(nw + c + 4 * n) * (*(const f32x4*)(modr + soff + c + 4 * n) + 1.0f);
                const f32x4 ap = *(const f32x4*)(pw + c + 4 * n) * (*(const f32x4*)(modr + poff + c + 4 * n) + 1.0f);
                ia[n][0] = __builtin_amdgcn_rcpf(ap[0]); ia[n][1] = __builtin_amdgcn_rcpf(ap[1]); ia[n][2] = __builtin_amdgcn_rcpf(ap[2]); ia[n][3] = __builtin_amdgcn_rcpf(ap[3]); }
#pragma unroll
            for (int am = 0; am < 4; ++am) { const int ai = am >> 1; u32x4 xr[2];
#pragma unroll
                for (int mm = 0; mm < 2; ++mm) xr[mm] = *(const u32x4*)(An + (size_t)(u.pm * 256 + ai * 128 + wr * 64 + ((am & 1) * 2 + mm) * 16 + fr) * 1024 + c);
#pragma unroll
                for (int mm = 0; mm < 2; ++mm) { const int m = (am & 1) * 2 + mm; const size_t row = (size_t)(u.pm * 256 + ai * 128 + wr * 64 + m * 16 + fr);
                    const f32x4 x0 = unpack4((u32x2){xr[mm].x, xr[mm].y}) * ia[0] + g[0] * acc[ai][bj][m][0], x1 = unpack4((u32x2){xr[mm].z, xr[mm].w}) * ia[1] + g[1] * acc[ai][bj][m][1];
                    ss[ai][m] += ((x0[0] * x0[0] + x0[1] * x0[1]) + (x0[2] * x0[2] + x0[3] * x0[3])) + ((x1[0] * x1[0] + x1[1] * x1[1]) + (x1[2] * x1[2] + x1[3] * x1[3]));
                    const u32x2 pa = pack4(x0 * a[0]), pb = pack4(x1 * a[1]); *(u32x4*)(An + row * 1024 + c) = (u32x4){pa.x, pa.y, pb.x, pb.y}; } } }
#pragma unroll
        for (int ai = 0; ai < 2; ++ai)
#pragma unroll
            for (int m = 0; m < 4; ++m) { float s = ss[ai][m]; s += __shfl_xor(s, 16); s += __shfl_xor(s, 32);
                if (fq == 0) ssq[(size_t)(u.pm * 256 + ai * 128 + wr * 64 + m * 16 + fr) * 16 + u.pn * 4 + wc] = s; }
    }
};
template <int ACT> struct EpiProj {
    static constexpr bool PERM = true, AFTER_DRAIN = false;
    bf16_t* O; const float* ssq; const float* cb; float* lnp;
    __device__ __forceinline__ void operator()(const f32x4 (&acc)[2][2][4][2], const Unit& u, int wr, int wc, int fr, int fq) const {
        float rsv[2][4];
#pragma unroll
        for (int ai = 0; ai < 2; ++ai)
#pragma unroll
            for (int m = 0; m < 4; ++m) rsv[ai][m] = row_rstd4(ssq, u.pm * 256 + ai * 128 + wr * 64 + m * 16 + fr, fq);
        f32x4 cbv[2][2];
        if (u.pm < 64) {
#pragma unroll
            for (int bj = 0; bj < 2; ++bj) { const float* cbr = cb + (size_t)(u.pm >> 3) * CBLD + u.pn * 256 + bj * 128 + wc * 32 + 8 * fq; cbv[bj][0] = *(const f32x4*)cbr; cbv[bj][1] = *(const f32x4*)(cbr + 4); } }
#pragma unroll
        for (int ai = 0; ai < 2; ++ai)
#pragma unroll
            for (int m = 0; m < 4; ++m) { const int row = u.pm * 256 + ai * 128 + wr * 64 + m * 16 + fr; const int b = row_b(row); const float rs = rsv[ai][m]; float s1 = 0.f, s2 = 0.f;
#pragma unroll
                for (int bj = 0; bj < 2; ++bj) { const int c0 = u.pn * 256 + bj * 128 + wc * 32 + 8 * fq; const float* cbr = cb + (size_t)b * CBLD + c0;
                    f32x4 c0v = cbv[bj][0], c1v = cbv[bj][1]; if (u.pm >= 64) { c0v = *(const f32x4*)(cbr); c1v = *(const f32x4*)(cbr + 4); }
                    f32x4 v0 = acc[ai][bj][m][0] * rs + c0v, v1 = acc[ai][bj][m][1] * rs + c1v;
                    if (ACT) {
#pragma unroll
                        for (int j = 0; j < 4; ++j) { v0[j] = gelu_tanh(v0[j]); v1[j] = gelu_tanh(v1[j]); }
                        s1 += ((v0[0] + v0[1]) + (v0[2] + v0[3])) + ((v1[0] + v1[1]) + (v1[2] + v1[3]));
                        s2 += ((v0[0] * v0[0] + v0[1] * v0[1]) + (v0[2] * v0[2] + v0[3] * v0[3])) + ((v1[0] * v1[0] + v1[1] * v1[1]) + (v1[2] * v1[2] + v1[3] * v1[3])); }
                    u32x4 w; w.x = cvt_pk_bf16(v0[0], v0[1]); w.y = cvt_pk_bf16(v0[2], v0[3]); w.z = cvt_pk_bf16(v1[0], v1[1]); w.w = cvt_pk_bf16(v1[2], v1[3]);
                    *(u32x4*)(O + (size_t)row * 4096 + c0) = w; }
                if (ACT) { s1 += __shfl_xor(s1, 16); s1 += __shfl_xor(s1, 32); s2 += __shfl_xor(s2, 16); s2 += __shfl_xor(s2, 32);
                    if (u.pn >= 8 && fq == 0) { float* q = lnp + ((size_t)row * 32 + (u.pn - 8) * 4 + wc) * 2; q[0] = s1; q[1] = s2; } } }
    }
};

struct SkArgs { const bf16_t* A; const bf16_t* Bt; int K, N; const float* cb; bf16_t* O; bf16_t* An; const float* mod; const float* nw; const float* pw; int goff, soff, poff; float coef; };
template <int MODE, int RT> __device__ __forceinline__ void skinny_phase(const Params& p, const SkArgs& a, int owner_kind, unsigned char* lds) {
    constexpr int NB = (RT == 2) ? 11 : 2, NRG = 8 / RT, RR = 16 * RT;
    const int tid = tidx(), lane = tid & 63, wv = __builtin_amdgcn_readfirstlane(tid >> 6), fr = lane & 15, fq = lane >> 4; const int G = gridDim.x, cid = blockIdx.x;
    float* ssqS = (float*)(p.ws + OFF_SSQS); float* lnpS = (float*)(p.ws + OFF_LNPS); float* red = (float*)lds;
    const int ncc = a.N >> 5, nch = ncc * NRG, K = a.K, ksl = K >> 3, nks = ksl >> 5, kb = wv * ksl;
    for (int jx = 0; jx < nch; ++jx) {
        int own; if (owner_kind == 0) own = (G >= 256) ? 128 + (jx & 127) : jx % G; else own = (2 * jx + ((jx >> 2) & 1)) % G;
        if (own != cid) continue;
        const int j = jx / NRG, rg = jx % NRG;
        int n0, n1; if (MODE == 0) { n0 = (j >> 3) * 256 + (j & 7) * 16; n1 = n0 + 128; } else { n0 = j * 32; n1 = n0 + 16; }
        f32x4 acc[RT][2];
#pragma unroll
        for (int m = 0; m < RT; ++m) { acc[m][0] = (f32x4){0.f, 0.f, 0.f, 0.f}; acc[m][1] = (f32x4){0.f, 0.f, 0.f, 0.f}; }
        const bf16_t* Ab = a.A + (size_t)(rg * RR + fr) * K + kb + 8 * fq; const bf16_t* B0 = a.Bt + (size_t)(n0 + fr) * K + kb + 8 * fq; const bf16_t* B1 = a.Bt + (size_t)(n1 + fr) * K + kb + 8 * fq;
#pragma unroll 1
        for (int ks0 = 0; ks0 < nks; ks0 += NB) { const int nb = min(NB, nks - ks0); bf16x8 af[NB][RT], bfr[NB][2];
#pragma unroll
            for (int s = 0; s < NB; ++s) if (s < nb) {
#pragma unroll
                for (int m = 0; m < RT; ++m) af[s][m] = *(const bf16x8*)(Ab + (size_t)m * 16 * K + (ks0 + s) * 32);
                bfr[s][0] = *(const bf16x8*)(B0 + (ks0 + s) * 32); bfr[s][1] = *(const bf16x8*)(B1 + (ks0 + s) * 32); }
#pragma unroll
            for (int s = 0; s < NB; ++s) if (s < nb) {
#pragma unroll
                for (int m = 0; m < RT; ++m) { acc[m][0] = __builtin_amdgcn_mfma_f32_16x16x32_bf16(bfr[s][0], af[s][m], acc[m][0], 0, 0, 0); acc[m][1] = __builtin_amdgcn_mfma_f32_16x16x32_bf16(bfr[s][1], af[s][m], acc[m][1], 0, 0, 0); } } }
#pragma unroll
        for (int m = 0; m < RT; ++m) { *(f32x4*)(red + (size_t)(wv * RR + 16 * m + fr) * 32 + 4 * fq) = acc[m][0]; *(f32x4*)(red + (size_t)(wv * RR + 16 * m + fr) * 32 + 16 + 4 * fq) = acc[m][1]; }
        __syncthreads();
        if (wv < RT) {
        const int rl = tid >> 2, q = tid & 3, r = rg * RR + rl, row = 16384 + r, b = 8 + r; f32x4 v0 = {0.f, 0.f, 0.f, 0.f}, v1 = {0.f, 0.f, 0.f, 0.f};
        const int o0 = (MODE == 0) ? 4 * q : 8 * q, o1 = (MODE == 0) ? 16 + 4 * q : 8 * q + 4;
#pragma unroll
        for (int w = 0; w < 8; ++w) { v0 += *(const f32x4*)(red + (size_t)(w * RR + rl) * 32 + o0); v1 += *(const f32x4*)(red + (size_t)(w * RR + rl) * 32 + o1); }
        if (MODE == 0) { const float rs = srow_rstd(ssqS, r); const float* cbr = a.cb + (size_t)b * CBLD;
            const f32x4 g = v0 * rs + *(const f32x4*)(cbr + n0 + 4 * q), uu = v1 * rs + *(const f32x4*)(cbr + n1 + 4 * q); f32x4 hh;
#pragma unroll
            for (int jj = 0; jj < 4; ++jj) hh[jj] = siluf_(g[jj]) * uu[jj];
            *(u32x2*)(a.O + (size_t)row * 2816 + (j >> 3) * 128 + (j & 7) * 16 + 4 * q) = pack4(hh); }
        else if (MODE == 1) { const int c = n0 + 8 * q; const float* modr = a.mod + (size_t)b * MODLD; bf16_t* xp = a.An + (size_t)row * 1024 + c; const u32x4 xw8 = *(const u32x4*)xp;
            const f32x4 p0 = *(const f32x4*)(a.pw + c) * (*(const f32x4*)(modr + a.poff + c) + 1.0f), p1 = *(const f32x4*)(a.pw + c + 4) * (*(const f32x4*)(modr + a.poff + c + 4) + 1.0f);
            f32x4 x0 = unpack4((u32x2){xw8.x, xw8.y}), x1 = unpack4((u32x2){xw8.z, xw8.w});
#pragma unroll
            for (int jj = 0; jj < 4; ++jj) { x0[jj] *= __builtin_amdgcn_rcpf(p0[jj]); x1[jj] *= __builtin_amdgcn_rcpf(p1[jj]); }
            const f32x4 g0 = *(const f32x4*)(modr + a.goff + c), g1 = *(const f32x4*)(modr + a.goff + c + 4);
            f32x4 a0 = {1.f, 1.f, 1.f, 1.f}, a1 = a0; if (a.nw) { a0 = *(const f32x4*)(a.nw + c) * (*(const f32x4*)(modr + a.soff + c) + 1.0f); a1 = *(const f32x4*)(a.nw + c + 4) * (*(const f32x4*)(modr + a.soff + c + 4) + 1.0f); }
            const f32x4 y0 = x0 + (g0 + 1.0f) * a.coef * v0, y1 = x1 + (g1 + 1.0f) * a.coef * v1;
            { const u32x2 pa = pack4(y0 * a0), pb = pack4(y1 * a1); *(u32x4*)xp = (u32x4){pa.x, pa.y, pb.x, pb.y}; }
            float ss = ((y0[0] * y0[0] + y0[1] * y0[1]) + (y0[2] * y0[2] + y0[3] * y0[3])) + ((y1[0] * y1[0] + y1[1] * y1[1]) + (y1[2] * y1[2] + y1[3] * y1[3]));
            ss += __shfl_xor(ss, 1); ss += __shfl_xor(ss, 2); if (q == 0) ssqS[r * 32 + j] = ss; }
        else { const int c = n0 + 8 * q; const float rs = srow_rstd(ssqS, r); const float* cbr = a.cb + (size_t)b * CBLD + c; f32x4 y0 = v0 * rs + *(const f32x4*)cbr, y1 = v1 * rs + *(const f32x4*)(cbr + 4);
            if (MODE == 3) {
#pragma unroll
                for (int jj = 0; jj < 4; ++jj) { y0[jj] = gelu_tanh(y0[jj]); y1[jj] = gelu_tanh(y1[jj]); }
                float s1 = ((y0[0] + y0[1]) + (y0[2] + y0[3])) + ((y1[0] + y1[1]) + (y1[2] + y1[3]));
                float s2 = ((y0[0] * y0[0] + y0[1] * y0[1]) + (y0[2] * y0[2] + y0[3] * y0[3])) + ((y1[0] * y1[0] + y1[1] * y1[1]) + (y1[2] * y1[2] + y1[3] * y1[3]));
                s1 += __shfl_xor(s1, 1); s1 += __shfl_xor(s1, 2); s2 += __shfl_xor(s2, 1); s2 += __shfl_xor(s2, 2);
                if (j >= 64 && q == 0) { lnpS[(r * 64 + (j - 64)) * 2] = s1; lnpS[(r * 64 + (j - 64)) * 2 + 1] = s2; } }
            const u32x2 pa = pack4(y0), pb = pack4(y1); *(u32x4*)(a.O + (size_t)row * 4096 + c) = (u32x4){pa.x, pa.y, pb.x, pb.y}; }
        }
        __syncthreads();
    }
}

__device__ void conv_job(const float* src, int K, int ldn, int N, int mode, bf16_t* dst, float* tile) {
    const int tid = tidx(); const int nkt = K >> 6, nt = nkt * (N >> 6);
    for (int t = blockIdx.x; t < nt; t += gridDim.x) {
        const int kt = t % nkt, ntile = t / nkt, n0 = ntile * 64, k0 = kt * 64;
        { const int nl = tid & 63, kk = tid >> 6, nd = n0 + nl; const int sc = mode ? (((nd >> 7) & 1) * 2816 + (nd >> 8) * 128 + (nd & 127)) : nd;
#pragma unroll
          for (int j = 0; j < 8; ++j) tile[(kk + 8 * j) * 65 + nl] = __builtin_nontemporal_load(src + (size_t)(k0 + kk + 8 * j) * ldn + sc); }
        __syncthreads();
        { const int k2 = (tid & 31) * 2, nr = tid >> 5;
#pragma unroll
          for (int j = 0; j < 4; ++j) { const int n = nr + 16 * j; *(unsigned*)(dst + (size_t)(n0 + n) * K + k0 + k2) = cvt_pk_bf16(tile[k2 * 65 + n], tile[(k2 + 1) * 65 + n]); } }
        __syncthreads();
    }
}
__device__ void phase_convert(const Params& p, unsigned char* lds) {
    float* tile = (float*)lds; bf16_t* W1 = (bf16_t*)(p.ws + OFF_W1);
    for (int i = 0; i < 4; ++i) {
        for (int f = 0; f < 2; ++f) {
            conv_job(p.w_gu + (size_t)(i * 2 + f) * 1024 * 5632, 1024, 5632, 5632, 1, W1 + (size_t)(i * 60 + (f ? 38 : 0)) * 256 * 1024, tile);
            conv_job(p.w_down + (size_t)(i * 2 + f) * 2816 * 1024, 2816, 1024, 1024, 0, (bf16_t*)(p.ws + OFF_WDN) + (size_t)(i * 2 + f) * 1024 * 2816, tile); }
        const int li = i >> 1;
        if ((i & 1) == 0) { conv_job(p.a_w_in + (size_t)li * 1024 * 4112, 1024, 4112, 4096, 0, W1 + (size_t)(i * 60 + 22) * 256 * 1024, tile);
                            conv_job(p.a_w_out + (size_t)li * 1024 * 1024, 1024, 1024, 1024, 0, (bf16_t*)(p.ws + OFF_WOA) + (size_t)li * 1024 * 1024, tile); }
        else { conv_job(p.b_w_in + (size_t)li * 1024 * 4096, 1024, 4096, 4096, 0, W1 + (size_t)(i * 60 + 22) * 256 * 1024, tile);
               conv_job(p.b_w_out + (size_t)li * 2048 * 1024, 2048, 1024, 1024, 0, (bf16_t*)(p.ws + OFF_WOB) + (size_t)li * 1024 * 2048, tile); }
        conv_job(p.w_ada + (size_t)i * 1024 * 9216, 1024, 9216, 9216, 0, (bf16_t*)(p.ws + OFF_R1) + (size_t)i * 9216 * 1024, tile);
    }
    const int gt = blockIdx.x * 512 + tidx(), gs = gridDim.x * 512;
    bf16_t* SC = (bf16_t*)(p.ws + OFF_SC);
    for (int e = gt; e < 256 * 1024; e += gs) { const int r = e >> 10, k = e & 1023; float v = 0.f; if (r < 8) v = p.c_prompt[r * 1024 + k]; else if (r < 136) v = p.c_sample[(r - 8) * 1024 + k]; SC[e] = f2bf(siluf_(v)); }
    float* WL = (float*)(p.ws + OFF_WLOG);
    for (int e = gt; e < 2 * 16 * 1024; e += gs) { const int li = e >> 14, j = (e >> 10) & 15, k = e & 1023; WL[e] = p.a_w_in[(size_t)li * 1024 * 4112 + (size_t)k * 4112 + 4096 + j]; }
}

__device__ void phase_prep0(const Params& p) {
    const int tid = tidx(), lane = tid & 63, gw = blockIdx.x * 8 + (tid >> 6), nw = gridDim.x * 8;
    const float* mod = (const float*)(p.ws + OFF_MOD);
    bf16_t* SH = (bf16_t*)(p.ws + OFF_SH);
    for (int e8 = blockIdx.x * 512 + tid; e8 < 12 * 256 * 128; e8 += gridDim.x * 512) { const int e = e8 * 8, site = e >> 18, r = (e >> 10) & 255, k = e & 1023; const int i = site / 3, sub = site % 3;
        f32x4 v0 = {0.f, 0.f, 0.f, 0.f}, v1 = v0; if (r < 136) { const float* q = mod + (size_t)r * MODLD + i * 9216 + sub * 3072 + k; v0 = *(const f32x4*)q; v1 = *(const f32x4*)(q + 4); }
        const u32x2 a = pack4(v0), b2 = pack4(v1); *(u32x4*)(SH + e) = (u32x4){a.x, a.y, b2.x, b2.y}; }
    bf16_t* An = (bf16_t*)(p.ws + OFF_AN); float* ssq = (float*)(p.ws + OFF_SSQ);
    for (int row = gw; row < MPAD; row += nw) {
        const float* src = row < 16384 ? p.x_prompt + (size_t)row * 1024 : (row < 16512 ? p.x_sample + (size_t)(row - 16384) * 1024 : nullptr);
        const int b = row_b(row); const float* modr = mod + (size_t)b * MODLD; float ss = 0.f;
#pragma unroll
        for (int j = 0; j < 4; ++j) { const int k = j * 256 + lane * 4; f32x4 x = {0.f, 0.f, 0.f, 0.f}; if (src) x = *(const f32x4*)(src + k);
            ss += (x[0] * x[0] + x[1] * x[1]) + (x[2] * x[2] + x[3] * x[3]);
            const f32x4 sc = *(const f32x4*)(modr + 1024 + k), w = *(const f32x4*)(p.norm_w + k); *(u32x2*)(An + (size_t)row * 1024 + k) = pack4(x * (w * (sc + 1.0f))); }
        ss = wsum(ss); if (row < 16384) { if (lane < 16) ssq[(size_t)row * 16 + lane] = lane == 0 ? ss : 0.f; } else if (row < 16512) { if (lane < 32) ((float*)(p.ws + OFF_SSQS))[(row - 16384) * 32 + lane] = lane == 0 ? ss : 0.f; }
    }
    const float* WL = (const float*)(p.ws + OFF_WLOG); float* cb16 = (float*)(p.ws + OFF_CB16);
    for (int t = gw; t < 2 * 136; t += nw) { const int li = t / 136, b = t % 136; const float* sh = mod + (size_t)b * MODLD + (2 * li) * 9216 + 3072;
        float shv[16];
#pragma unroll
        for (int kk = 0; kk < 16; ++kk) shv[kk] = sh[kk * 64 + lane];
#pragma unroll 1
        for (int j4 = 0; j4 < 16; j4 += 4) { float wv_[4][16];
#pragma unroll
            for (int jj = 0; jj < 4; ++jj)
#pragma unroll
                for (int kk = 0; kk < 16; ++kk) wv_[jj][kk] = WL[(size_t)(li * 16 + j4 + jj) * 1024 + kk * 64 + lane];
#pragma unroll
            for (int jj = 0; jj < 4; ++jj) { float s = 0.f;
#pragma unroll
                for (int kk = 0; kk < 16; ++kk) s += shv[kk] * wv_[jj][kk];
                s = wsum(s); if (lane == 0) cb16[t * 16 + j4 + jj] = s; } } }
}

__device__ void phase_final(const Params& p) {
    const int tid = tidx(), lane = tid & 63, gw = blockIdx.x * 8 + (tid >> 6), nw = gridDim.x * 8;
    const bf16_t* X = (const bf16_t*)(p.ws + OFF_AN); const float* ssq = (const float*)(p.ws + OFF_SSQ);
    for (int row = gw; row < 16512; row += nw) { const float rs = row < 16384 ? row_rstd(ssq, row) : srow_rstd((const float*)(p.ws + OFF_SSQS), row - 16384);
#pragma unroll
        for (int j = 0; j < 4; ++j) { const int k = j * 256 + lane * 4; const f32x4 x = unpack4(*(const u32x2*)(X + (size_t)row * 1024 + k)), w = *(const f32x4*)(p.final_w + k);
            *(f32x4*)(p.out + OUT_Y + (size_t)row * 1024 + k) = x * rs * w; } }
}

__device__ void prep_phase(const Params& p, int li, unsigned char* lds) {
    const int tid0 = tidx(), wv = __builtin_amdgcn_readfirstlane(tid0 >> 6);
    float* MT = (float*)lds; float* sm = (float*)(lds + 17408); bf16_t* kn = (bf16_t*)(lds + 19456); bf16_t* qn = (bf16_t*)(lds + 36864); bf16_t* at = (bf16_t*)(lds + 54272); float* vf = (float*)(lds + 63488); bf16_t* mb = (bf16_t*)(lds + 97280); bf16_t* db = (bf16_t*)(lds + 106496); bf16_t* wb = (bf16_t*)(lds + 109568);
    const bf16_t* PROJ = (const bf16_t*)(p.ws + OFF_PROJ); const bf16_t* An = (const bf16_t*)(p.ws + OFF_AN); const float* ssq = (const float*)(p.ws + OFF_SSQ);
    const float* WL = (const float*)(p.ws + OFF_WLOG); const float* cb16 = (const float*)(p.ws + OFF_CB16);
    const float* wconv = p.a_w_conv + (size_t)li * 4 * 3072;
    float* wl = (float*)(lds + 130048); int hcur = -1;
    const int vb = (gridDim.x % 8 == 0) ? (int)(blockIdx.x & 7) * (int)(gridDim.x >> 3) + (int)(blockIdx.x >> 3) : (int)blockIdx.x;
    for (int item = vb; item < 2048; item += gridDim.x) {
        int tid_ = tid0; asm volatile("" : "+v"(tid_));
        const int tid = tid_, lane = tid & 63, fr = lane & 15, fq = lane >> 4;
        const int b = item >> 8, n = (item >> 3) & 31, h = item & 7; const int row0 = b * 2048 + n * 64;
        unsigned char* dst = p.ws + OFF_R1 + (size_t)item * ITEM_BYTES;
        if (h != hcur) { hcur = h;
            for (int e = tid; e < 2048; e += 512) { const int which = e >> 10, k = e & 1023; wl[which * 1056 + (k >> 7) * 132 + (k & 127)] = WL[(size_t)(li * 16 + which * 8 + h) * 1024 + k]; }
            lds_barrier(); }
#ifdef MK_PROBE_PREPFRONT
        for (int rep_ = 0; rep_ < 2; ++rep_) {
#endif
        if (wv < 6) { const int c8 = tid % 48, run = tid / 48, seg = c8 >> 4, ch = (c8 & 15) * 8, col = seg * 1024 + h * 128 + ch, tok0 = run * 8;
            u32x4 xr[11];
#pragma unroll
            for (int r = 0; r < 11; ++r) { const int pos = n * 64 + tok0 - 3 + r; xr[r] = (u32x4){0u, 0u, 0u, 0u}; if (pos >= 0) xr[r] = *(const u32x4*)(PROJ + (size_t)(b * 2048 + pos) * 4096 + col); }
            f32x4 cw[4][2];
#pragma unroll
            for (int j = 0; j < 4; ++j) { cw[j][0] = *(const f32x4*)(wconv + j * 3072 + col); cw[j][1] = *(const f32x4*)(wconv + j * 3072 + col + 4); }
#pragma unroll
            for (int t = 0; t < 8; ++t) { const int tok = tok0 + t; f32x4 a0 = {0.f, 0.f, 0.f, 0.f}, a1 = a0;
#pragma unroll
                for (int j = 0; j < 4; ++j) { a0 += unpack4((u32x2){xr[t + j].x, xr[t + j].y}) * cw[j][0]; a1 += unpack4((u32x2){xr[t + j].z, xr[t + j].w}) * cw[j][1]; }
                f32x4 s0, s1;
#pragma unroll
                for (int j = 0; j < 4; ++j) { s0[j] = siluf_(a0[j]); s1[j] = siluf_(a1[j]); }
                const float ss = row16_sum(((s0[0] * s0[0] + s0[1] * s0[1]) + (s0[2] * s0[2] + s0[3] * s0[3])) + ((s1[0] * s1[0] + s1[1] * s1[1]) + (s1[2] * s1[2] + s1[3] * s1[3])));
                const float rn = rsqrtf(ss + 1e-6f);
                if (seg == 0) { const float sc = rn * 0.08838834764831845f; const u32x2 pa = pack4(s0 * sc), pb = pack4(s1 * sc); *(u32x4*)(qn + tok * 136 + ch) = (u32x4){pa.x, pa.y, pb.x, pb.y}; }
                else if (seg == 1) { const u32x2 pa = pack4(s0 * rn), pb = pack4(s1 * rn); *(u32x4*)(kn + tok * 136 + ch) = (u32x4){pa.x, pa.y, pb.x, pb.y}; }
                else { *(f32x4*)(vf + tok * 132 + ch) = s0; *(f32x4*)(vf + tok * 132 + ch + 4) = s1; } } }
        if (n == 31) for (int e = tid; e < 3 * 384; e += 512) { const int r = e / 384, cc = e % 384, col = (cc >> 7) * 1024 + h * 128 + (cc & 127);
            p.out[OUT_CONVP + ((size_t)(li * 8 + b) * 3 + r) * 3072 + col] = bf2f(PROJ[(size_t)(b * 2048 + 2045 + r) * 4096 + col]); }
        { const int tok = tid >> 3, part = tid & 7, row = row0 + tok; const bf16_t* ar = An + (size_t)row * 1024 + part * 128;
          const float* w1 = wl + part * 132; const float* w2 = wl + 1056 + part * 132; float s1 = 0.f, s2 = 0.f;
#pragma unroll 1
          for (int kh = 0; kh < 2; ++kh) { u32x4 xw[8];
#pragma unroll
              for (int kk = 0; kk < 8; ++kk) xw[kk] = *(const u32x4*)(ar + (kh * 8 + kk) * 8);
#pragma unroll
              for (int kk = 0; kk < 8; ++kk) { const int ko = (kh * 8 + kk) * 8; const f32x4 x0 = unpack4((u32x2){xw[kk].x, xw[kk].y}), x1 = unpack4((u32x2){xw[kk].z, xw[kk].w});
                  const f32x4 a0 = *(const f32x4*)(w1 + ko), a1 = *(const f32x4*)(w1 + ko + 4), c0 = *(const f32x4*)(w2 + ko), c1 = *(const f32x4*)(w2 + ko + 4);
#pragma unroll
                  for (int j = 0; j < 4; ++j) { s1 += x0[j] * a0[j] + x1[j] * a1[j]; s2 += x0[j] * c0[j] + x1[j] * c1[j]; } } }
          s1 += __shfl_xor(s1, 1); s1 += __shfl_xor(s1, 2); s1 += __shfl_xor(s1, 4); s2 += __shfl_xor(s2, 1); s2 += __shfl_xor(s2, 2); s2 += __shfl_xor(s2, 4);
          if (part == 0) { const float rs = row_rstd(ssq, row); const float bl = rs * s1 + cb16[(li * 136 + b) * 16 + h], al = rs * s2 + cb16[(li * 136 + b) * 16 + 8 + h] + p.a_dt_bias[li * 8 + h];
              const float sp = fmaxf(al, 0.f) + log1pf(__expf(-fabsf(al))); sm[tok] = sigmoidf_(bl); sm[64 + tok] = -__expf(p.a_log[li * 8 + h]) * sp; } }
        lds_barrier();
        if (wv == 0) { float d = sm[64 + lane];
#pragma unroll
            for (int o = 1; o < 64; o <<= 1) { const float t = __shfl_up(d, o); if (lane >= o) d += t; }
            sm[128 + lane] = d; sm[192 + lane] = __expf(d); }
        lds_barrier();
        { const int gram = wv >> 2, i = wv & 3; const bf16_t* src = gram ? qn : kn; bf16x8 a[4];
#pragma unroll
          for (int t = 0; t < 4; ++t) a[t] = *(const bf16x8*)(src + (16 * i + fr) * 136 + 32 * t + 8 * fq);
          for (int j = 0; j < 4; ++j) { f32x4 acc = {0.f, 0.f, 0.f, 0.f};
              if (j <= i) {
#pragma unroll
                  for (int t = 0; t < 4; ++t) { const bf16x8 bb = *(const bf16x8*)(kn + (16 * j + fr) * 136 + 32 * t + 8 * fq); acc = __builtin_amdgcn_mfma_f32_16x16x32_bf16(a[t], bb, acc, 0, 0, 0); } }
              const int s = 16 * j + fr; const float ds = sm[128 + s];
#pragma unroll
              for (int idx = 0; idx < 4; ++idx) { const int c = 16 * i + 4 * fq + idx; const float gam = __expf(sm[128 + c] - ds);
                  if (gram == 0) { const float mv = (c > s) ? sm[c] * acc[idx] * gam : 0.f; MT[s * 68 + c] = mv; mb[c * 72 + s] = f2bf(mv); }
                  else at[c * 72 + s] = f2bf((c >= s) ? acc[idx] * gam : 0.f); } } }
        lds_barrier();
#ifdef MK_PROBE_PREPFRONT
        }
#endif
        if (wv == 0) { const int bi_ = lane >> 4, cc = lane & 15; const float* Md = MT + (16 * bi_) * 68 + 16 * bi_; float x[16];
#pragma unroll
            for (int r = 0; r < 16; ++r) x[r] = (r == cc) ? 1.0f : 0.0f;
#pragma unroll
            for (int q = 0; q < 15; ++q) { f32x4 mr[4];
#pragma unroll
                for (int g4 = 0; g4 < 4; ++g4) if (4 * g4 + 3 > q) mr[g4] = *(const f32x4*)(Md + q * 68 + 4 * g4);
#pragma unroll
                for (int r = q + 1; r < 16; ++r) x[r] -= mr[r >> 2][r & 3] * x[q]; }
#pragma unroll
            for (int r = 0; r < 16; ++r) db[(bi_ * 16 + r) * 24 + cc] = f2bf(x[r]);
        } else {
            const int t2 = tid - 64; const float dl = sm[128 + 63];
            for (int e = t2; e < 1024; e += 448) { const int ln = e & 63, f = e >> 6, i = f >> 2, t = f & 3, r_ = ln & 15, q_ = ln >> 4; const int c = 16 * i + r_; const float sc = sm[192 + c];
                const u32x2 lo = *(const u32x2*)(qn + c * 136 + 32 * t + 4 * q_), hi = *(const u32x2*)(qn + c * 136 + 32 * t + 16 + 4 * q_);
                const u32x2 a = pack4(unpack4(lo) * sc), bq = pack4(unpack4(hi) * sc); *(u32x4*)(dst + 16384 + (size_t)e * 16) = (u32x4){a.x, a.y, bq.x, bq.y}; }
            for (int e = t2; e < 1024; e += 448) { const int ln = e & 63, f = e >> 6, j = f >> 1, tt = f & 1, r_ = ln & 15, q_ = ln >> 4; const int kd = 16 * j + r_; f32x4 lo, hi;
#pragma unroll
                for (int s = 0; s < 4; ++s) { const int c0 = 32 * tt + 4 * q_ + s, c1 = c0 + 16; lo[s] = bf2f(kn[c0 * 136 + kd]) * __expf(dl - sm[128 + c0]); hi[s] = bf2f(kn[c1 * 136 + kd]) * __expf(dl - sm[128 + c1]); }
                const u32x2 a = pack4(lo), bq = pack4(hi); *(u32x4*)(dst + 32768 + (size_t)e * 16) = (u32x4){a.x, a.y, bq.x, bq.y}; }
            for (int e = t2; e < 512; e += 448) { const int ln = e & 63, f = e >> 6, i = f >> 1, tt = f & 1, r_ = ln & 15, q_ = ln >> 4; const int c = 16 * i + r_;
                const u32x2 lo = *(const u32x2*)(at + c * 72 + 32 * tt + 4 * q_), hi = *(const u32x2*)(at + c * 72 + 32 * tt + 16 + 4 * q_);
                *(u32x4*)(dst + 49152 + (size_t)e * 16) = (u32x4){lo.x, lo.y, hi.x, hi.y}; }
            if (t2 == 0) *(float*)(dst + 73728) = __expf(dl);
        }
        lds_barrier();
        { f32x4 sol[4][2]; const bool isv = wv < 4;
#pragma unroll
          for (int ib = 0; ib < 4; ++ib) { f32x4 R[2]; __builtin_amdgcn_sched_barrier(0);
#pragma unroll
              for (int ct = 0; ct < 2; ++ct) { const int colg = 32 * wv + 16 * ct + fr;
#pragma unroll
                  for (int idx = 0; idx < 4; ++idx) { const int c = 16 * ib + 4 * fq + idx; const float rv = vf[c * 132 + (colg & 127)], rk_ = bf2f(kn[c * 136 + (colg & 127)]) * sm[192 + c]; R[ct][idx] = (isv ? rv : rk_) * sm[c]; } }
              if (ib > 0) { f32x4 P[2] = {{0.f, 0.f, 0.f, 0.f}, {0.f, 0.f, 0.f, 0.f}};
#pragma unroll
                  for (int t = 0; t <= (ib - 1) / 2; ++t) { const bool two = (2 * t + 1 < ib);
                      const u32x2 lo = *(const u32x2*)(mb + (16 * ib + fr) * 72 + 32 * t + 4 * fq); u32x2 hi = {0u, 0u}; if (two) hi = *(const u32x2*)(mb + (16 * ib + fr) * 72 + 32 * t + 16 + 4 * fq);
                      const bf16x8 af = __builtin_bit_cast(bf16x8, (u32x4){lo.x, lo.y, hi.x, hi.y});
#pragma unroll
                      for (int ct = 0; ct < 2; ++ct) { const f32x4 z4 = {0.f, 0.f, 0.f, 0.f}; const bf16x8 bfg = pack8(sol[2 * t][ct], two ? sol[2 * t + 1][ct] : z4);
                          P[ct] = __builtin_amdgcn_mfma_f32_16x16x32_bf16(af, bfg, P[ct], 0, 0, 0); } }
                  R[0] = R[0] - P[0]; R[1] = R[1] - P[1]; }
              { const u32x2 lo = *(const u32x2*)(db + (ib * 16 + fr) * 24 + 4 * fq); const bf16x8 df = __builtin_bit_cast(bf16x8, (u32x4){lo.x, lo.y, 0u, 0u});
#pragma unroll
                for (int ct = 0; ct < 2; ++ct) { const f32x4 z4 = {0.f, 0.f, 0.f, 0.f}; sol[ib][ct] = __builtin_amdgcn_mfma_f32_16x16x32_bf16(df, pack8(R[ct], z4), z4, 0, 0, 0); } } }
          if (isv) {
#pragma unroll
              for (int ib = 0; ib < 4; ++ib)
#pragma unroll
                  for (int ct = 0; ct < 2; ++ct) *(u32x2*)(dst + 57344 + (size_t)((ib * 8 + 2 * wv + ct) * 64 + lane) * 8) = pack4(sol[ib][ct]);
          } else {
#pragma unroll
              for (int ib = 0; ib < 4; ++ib)
#pragma unroll
                  for (int ct = 0; ct < 2; ++ct)
#pragma unroll
                      for (int idx = 0; idx < 4; ++idx) wb[(16 * ib + 4 * fq + idx) * 136 + 32 * (wv - 4) + 16 * ct + fr] = f2bf(sol[ib][ct][idx]); } }
        lds_barrier();
        for (int e = tid; e < 1024; e += 512) { const int ln = e & 63, f = e >> 6, i = f >> 2, t = f & 3, r_ = ln & 15, q_ = ln >> 4; const int c = 16 * i + r_;
            const u32x2 lo = *(const u32x2*)(wb + c * 136 + 32 * t + 4 * q_), hi = *(const u32x2*)(wb + c * 136 + 32 * t + 16 + 4 * q_);
            *(u32x4*)(dst + (size_t)e * 16) = (u32x4){lo.x, lo.y, hi.x, hi.y}; }
        lds_barrier();
    }
}

__device__ void scan_block(const Params& p, int li, int bh, unsigned char* lds) {
    const int tid = tidx(), lane = tid & 63, wv = __builtin_amdgcn_readfirstlane(tid >> 6), fr = lane & 15, fq = lane >> 4; const int b = bh >> 3, h = bh & 7;
    float* red = (float*)(lds + 114688);
    const bf16_t* PROJ = (const bf16_t*)(p.ws + OFF_PROJ); bf16_t* OA = (bf16_t*)(p.ws + OFF_OAB);
    const unsigned char* base = p.ws + OFF_R1 + (size_t)((b * 32) * 8 + h) * ITEM_BYTES; const size_t cstride = 8 * ITEM_BYTES;
    f32x4 S[8];
#pragma unroll
    for (int j = 0; j < 8; ++j) S[j] = (f32x4){0.f, 0.f, 0.f, 0.f};
    u32x4 st[7]; u32x2 ucur[4], unext[4]; float elc, eln;
#pragma unroll
    for (int j = 0; j < 7; ++j) st[j] = *(const u32x4*)(base + (size_t)(j * 512 + tid) * 16);
#pragma unroll
    for (int i = 0; i < 4; ++i) ucur[i] = *(const u32x2*)(base + 57344 + (size_t)((i * 8 + wv) * 64 + lane) * 8);
    elc = *(const float*)(base + 73728);
#pragma unroll
    for (int j = 0; j < 7; ++j) *(u32x4*)(lds + (size_t)(j * 512 + tid) * 16) = st[j];
    lds_barrier();
    const f32x4 wn4 = *(const f32x4*)(p.a_w_onorm + li * 128 + 16 * wv + 4 * fq);
    for (int n = 0; n < 32; ++n) {
        const unsigned char* nb = base + (size_t)(n + 1) * cstride;
        if (n + 1 < 32) {
#pragma unroll
            for (int j = 0; j < 7; ++j) st[j] = *(const u32x4*)(nb + (size_t)(j * 512 + tid) * 16);
#pragma unroll
            for (int i = 0; i < 4; ++i) unext[i] = *(const u32x2*)(nb + 57344 + (size_t)((i * 8 + wv) * 64 + lane) * 8);
            eln = *(const float*)(nb + 73728);
        }
        u32x2 zv[4];
#pragma unroll
        for (int i = 0; i < 4; ++i) zv[i] = *(const u32x2*)(PROJ + ((size_t)b * 2048 + n * 64 + 16 * i + fr) * 4096 + 3072 + h * 128 + 16 * wv + 4 * fq);
        const unsigned char* buf = lds + (size_t)(n & 1) * 57344;
        bf16x8 Sb[4];
#pragma unroll
        for (int t = 0; t < 4; ++t) Sb[t] = pack8(S[2 * t], S[2 * t + 1]);
        f32x4 vnew[4];
#pragma unroll
        for (int i = 0; i < 4; ++i) vnew[i] = (f32x4){0.f, 0.f, 0.f, 0.f};
#pragma unroll
        for (int th = 0; th < 2; ++th) { bf16x8 wf[8];
#pragma unroll
            for (int f = 0; f < 8; ++f) wf[f] = *(const bf16x8*)(buf + (size_t)(((f >> 1) * 4 + 2 * th + (f & 1)) * 64 + lane) * 16);
            __builtin_amdgcn_sched_barrier(0);
#pragma unroll
            for (int tt = 0; tt < 2; ++tt)
#pragma unroll
                for (int i = 0; i < 4; ++i) vnew[i] = __builtin_amdgcn_mfma_f32_16x16x32_bf16(wf[i * 2 + tt], Sb[2 * th + tt], vnew[i], 0, 0, 0);
            __builtin_amdgcn_sched_barrier(0); }
#pragma unroll
        for (int i = 0; i < 4; ++i) vnew[i] = unpack4(ucur[i]) - vnew[i];
        bf16x8 vb[2];
#pragma unroll
        for (int t = 0; t < 2; ++t) vb[t] = pack8(vnew[2 * t], vnew[2 * t + 1]);
        f32x4 o[4];
#pragma unroll
        for (int i = 0; i < 4; ++i) o[i] = (f32x4){0.f, 0.f, 0.f, 0.f};
#pragma unroll
        for (int th = 0; th < 2; ++th) { bf16x8 qf[8];
#pragma unroll
            for (int f = 0; f < 8; ++f) qf[f] = *(const bf16x8*)(buf + 16384 + (size_t)(((f >> 1) * 4 + 2 * th + (f & 1)) * 64 + lane) * 16);
            __builtin_amdgcn_sched_barrier(0);
#pragma unroll
            for (int tt = 0; tt < 2; ++tt)
#pragma unroll
                for (int i = 0; i < 4; ++i) o[i] = __builtin_amdgcn_mfma_f32_16x16x32_bf16(Sb[2 * th + tt], qf[i * 2 + tt], o[i], 0, 0, 0);
            __builtin_amdgcn_sched_barrier(0); }
        { bf16x8 af[8];
#pragma unroll
          for (int f = 0; f < 8; ++f) af[f] = *(const bf16x8*)(buf + 49152 + (size_t)(f * 64 + lane) * 16);
          __builtin_amdgcn_sched_barrier(0);
#pragma unroll
          for (int t = 0; t < 2; ++t)
#pragma unroll
              for (int i = 0; i < 4; ++i) o[i] = __builtin_amdgcn_mfma_f32_16x16x32_bf16(vb[t], af[i * 2 + t], o[i], 0, 0, 0);
          __builtin_amdgcn_sched_barrier(0); }
#pragma unroll
        for (int jh = 0; jh < 2; ++jh) { bf16x8 kf[8];
#pragma unroll
            for (int f = 0; f < 8; ++f) kf[f] = *(const bf16x8*)(buf + 32768 + (size_t)((jh * 8 + f) * 64 + lane) * 16);
            __builtin_amdgcn_sched_barrier(0);
#pragma unroll
            for (int jj = 0; jj < 4; ++jj) S[jh * 4 + jj] = S[jh * 4 + jj] * elc;
#pragma unroll
            for (int t = 0; t < 2; ++t)
#pragma unroll
                for (int jj = 0; jj < 4; ++jj) S[jh * 4 + jj] = __builtin_amdgcn_mfma_f32_16x16x32_bf16(kf[jj * 2 + t], vb[t], S[jh * 4 + jj], 0, 0, 0);
            __builtin_amdgcn_sched_barrier(0); }
        float* rd = red + (n & 1) * 512;
        { float qs[4];
#pragma unroll
          for (int i = 0; i < 4; ++i) { float q = (o[i][0] * o[i][0] + o[i][1] * o[i][1]) + (o[i][2] * o[i][2] + o[i][3] * o[i][3]); q += __shfl_xor(q, 16); q += __shfl_xor(q, 32); qs[i] = q; }
          if (fq == 0) {
#pragma unroll
              for (int i = 0; i < 4; ++i) rd[(16 * i + fr) * 8 + wv] = qs[i]; } }
        if (n + 1 < 32) { unsigned char* ob = lds + (size_t)((n + 1) & 1) * 57344;
#pragma unroll
            for (int j = 0; j < 7; ++j) *(u32x4*)(ob + (size_t)(j * 512 + tid) * 16) = st[j]; }
        lds_barrier();
        { f32x4 r0[4], r1[4];
#pragma unroll
          for (int i = 0; i < 4; ++i) { const int c = 16 * i + fr; r0[i] = *(const f32x4*)(rd + c * 8); r1[i] = *(const f32x4*)(rd + c * 8 + 4); }
#pragma unroll
          for (int i = 0; i < 4; ++i) { const int c = 16 * i + fr;
              const float ssq_ = ((r0[i][0] + r0[i][1]) + (r0[i][2] + r0[i][3])) + ((r1[i][0] + r1[i][1]) + (r1[i][2] + r1[i][3])); const float rs = rsqrtf(ssq_ * (1.0f / 128.0f) + 1e-6f);
              const size_t row = (size_t)b * 2048 + n * 64 + c; const f32x4 z = unpack4(zv[i]); f32x4 y;
#pragma unroll
              for (int idx = 0; idx < 4; ++idx) y[idx] = o[i][idx] * rs * wn4[idx] * siluf_(z[idx]);
              *(u32x2*)(OA + row * 1024 + h * 128 + 16 * wv + 4 * fq) = pack4(y); } }
        if (n + 1 < 32) {
#pragma unroll
            for (int i = 0; i < 4; ++i) ucur[i] = unext[i];
            elc = eln; }
    }
    float* So = p.out + OUT_SP + (size_t)((li * 8 + b) * 8 + h) * 16384;
#pragma unroll
    for (int j = 0; j < 8; ++j)
#pragma unroll
        for (int idx = 0; idx < 4; ++idx) So[(16 * j + 4 * fq + idx) * 128 + 16 * wv + fr] = S[j][idx];
    lds_barrier();
}

__device__ void sampleA_item(const Params& p, int li, int sb, int h, unsigned char* lds) {
    const int tid = tidx(), lane = tid & 63, wv = __builtin_amdgcn_readfirstlane(tid >> 6); const int row = 16384 + sb;
    float* qkv = (float*)lds; float* redA = qkv + 384; float* red1 = redA + 64; float* red2 = red1 + 512; float* scal = red2 + 512;
    const bf16_t* PROJ = (const bf16_t*)(p.ws + OFF_PROJ); const bf16_t* An = (const bf16_t*)(p.ws + OFF_AN); bf16_t* OA = (bf16_t*)(p.ws + OFF_OAB);
    if (tid < 384) { const int seg = tid >> 7, ch = tid & 127, col = seg * 1024 + h * 128 + ch; const float* stc = p.st_conv + (size_t)(li * 128 + sb) * 3 * 3072 + col;
        const float s0 = stc[0], s1 = stc[3072], s2 = stc[6144], xn = bf2f(PROJ[(size_t)row * 4096 + col]); const float* w = p.a_w_conv + (size_t)li * 4 * 3072 + col;
        qkv[tid] = siluf_(s0 * w[0] + s1 * w[3072] + s2 * w[6144] + xn * w[9216]);
        float* co = p.out + OUT_CONVS + (size_t)(li * 128 + sb) * 3 * 3072 + col; co[0] = s1; co[3072] = s2; co[6144] = xn; }
    { const float* WL = (const float*)(p.ws + OFF_WLOG); const int k = tid * 2; const float x0 = bf2f(An[(size_t)row * 1024 + k]), x1 = bf2f(An[(size_t)row * 1024 + k + 1]);
      const float* w1 = WL + (size_t)(li * 16 + h) * 1024 + k; const float* w2 = WL + (size_t)(li * 16 + 8 + h) * 1024 + k;
      float s1 = x0 * w1[0] + x1 * w1[1], s2 = x0 * w2[0] + x1 * w2[1]; s1 = wsum(s1); s2 = wsum(s2); if (lane == 0) { redA[wv] = s1; redA[8 + wv] = s2; } }
    __syncthreads();
    if (wv == 0) { float q = qkv[lane] * qkv[lane] + qkv[64 + lane] * qkv[64 + lane]; q = wsum(q); if (lane == 0) scal[0] = rsqrtf(q + 1e-6f) * 0.08838834764831845f; }
    if (wv == 1) { float q = qkv[128 + lane] * qkv[128 + lane] + qkv[192 + lane] * qkv[192 + lane]; q = wsum(q); if (lane == 0) scal[1] = rsqrtf(q + 1e-6f); }
    if (tid == 128) { float s1 = 0.f, s2 = 0.f; for (int j = 0; j < 8; ++j) { s1 += redA[j]; s2 += redA[8 + j]; }
        const float rs = srow_rstd((const float*)(p.ws + OFF_SSQS), sb); const float* cb16 = (const float*)(p.ws + OFF_CB16) + (size_t)(li * 136 + 8 + sb) * 16;
        const float bl = rs * s1 + cb16[h], al = rs * s2 + cb16[8 + h] + p.a_dt_bias[li * 8 + h]; const float sp = fmaxf(al, 0.f) + log1pf(__expf(-fabsf(al)));
        scal[2] = sigmoidf_(bl); scal[3] = __expf(-__expf(p.a_log[li * 8 + h]) * sp); }
    __syncthreads();
    const float rq = scal[0], rk = scal[1], beta = scal[2], eg = scal[3];
    const int v = tid & 127, kq = tid >> 7;
    const float* S0 = p.st_S + ((size_t)((li * 128 + sb) * 8 + h) * 128 + kq * 32) * 128 + v; float s[32]; float part = 0.f;
#pragma unroll
    for (int kk = 0; kk < 32; ++kk) { s[kk] = __builtin_nontemporal_load(S0 + kk * 128); part += s[kk] * (qkv[128 + kq * 32 + kk] * rk); }
    red1[kq * 128 + v] = part;
    __syncthreads();
    const float kv = (red1[v] + red1[128 + v]) + (red1[256 + v] + red1[384 + v]); const float vnew = beta * (qkv[256 + v] - eg * kv);
    float* So = p.out + OUT_SS + ((size_t)((li * 128 + sb) * 8 + h) * 128 + kq * 32) * 128 + v; float po = 0.f;
#pragma unroll
    for (int kk = 0; kk < 32; ++kk) { const float sn = eg * s[kk] + (qkv[128 + kq * 32 + kk] * rk) * vnew; __builtin_nontemporal_store(sn, So + kk * 128); po += sn * (qkv[kq * 32 + kk] * rq); }
    red2[kq * 128 + v] = po;
    __syncthreads();
    float o = 0.f;
    if (tid < 128) { o = (red2[v] + red2[128 + v]) + (red2[256 + v] + red2[384 + v]); const float q = wsum(o * o); if (lane == 0) scal[4 + wv] = q; }
    __syncthreads();
    if (tid < 128) { const float rs = rsqrtf((scal[4] + scal[5]) * (1.0f / 128.0f) + 1e-6f); const float z = bf2f(PROJ[(size_t)row * 4096 + 3072 + h * 128 + v]);
        OA[(size_t)row * 1024 + h * 128 + v] = f2bf(o * rs * p.a_w_onorm[li * 128 + v] * siluf_(z)); }
    __syncthreads();
}

__device__ void mixB_phase(const Params& p, int li, unsigned char* lds) {
    const int tid = tidx(), lane = tid & 63, wv = __builtin_amdgcn_readfirstlane(tid >> 6), fr = lane & 15, fq = lane >> 4;
    bf16_t* vT = (bf16_t*)lds; float* stt = (float*)(lds + 69632);
    const bf16_t* UV = (const bf16_t*)(p.ws + OFF_PROJ); bf16_t* OB = (bf16_t*)(p.ws + OFF_OAB); const float* lnp = (const float*)(p.ws + OFF_LNP);
    const float* vw = p.b_vnorm_w + li * 2048; const float* vbias = p.b_vnorm_b + li * 2048;
    { const int gw = blockIdx.x * 8 + wv; if (gw < 128) { const int row = 16384 + gw; const float* lnpS = (const float*)(p.ws + OFF_LNPS); float s1 = lnpS[(gw * 64 + lane) * 2], s2 = lnpS[(gw * 64 + lane) * 2 + 1];
        s1 = wsum(s1); s2 = wsum(s2); const float mean = s1 * (1.0f / 2048.0f), rstd = rsqrtf(fmaxf(s2 * (1.0f / 2048.0f) - mean * mean, 0.f) + 1e-6f);
#pragma unroll
        for (int jj = 0; jj < 4; ++jj) { const int c = (jj * 64 + lane) * 8, g = c >> 8; const u32x4 vw4 = *(const u32x4*)(UV + (size_t)row * 4096 + 2048 + c), uw4 = *(const u32x4*)(UV + (size_t)row * 4096 + c);
            const f32x4 v0 = unpack4((u32x2){vw4.x, vw4.y}), v1 = unpack4((u32x2){vw4.z, vw4.w}), u0 = unpack4((u32x2){uw4.x, uw4.y}), u1 = unpack4((u32x2){uw4.z, uw4.w});
            const f32x4 n0 = (v0 - mean) * rstd * *(const f32x4*)(vw + c) + *(const f32x4*)(vbias + c), n1 = (v1 - mean) * rstd * *(const f32x4*)(vw + c + 4) + *(const f32x4*)(vbias + c + 4);
            float* vo = p.out + OUT_VS + (size_t)(li * 128 + gw) * 2048 + c; *(f32x4*)vo = n0; *(f32x4*)(vo + 4) = n1;
            const float w00 = p.b_w_s[(size_t)(li * 8 + g) * 16384], bs0 = p.b_b_s[(li * 8 + g) * 128];
            const f32x4 m0 = n0 * w00 + bs0, m1 = n1 * w00 + bs0; const u32x2 a = pack4(u0 * m0), bq = pack4(u1 * m1);
            *(u32x4*)(OB + (size_t)row * 2048 + c) = (u32x4){a.x, a.y, bq.x, bq.y}; } } }
    for (int item = blockIdx.x; item < 1024; item += gridDim.x) {
        const int b = item >> 7, n = (item >> 3) & 15, g = item & 7; const int row0 = b * 2048 + n * 128;
        if (tid < 128) { const float* q = lnp + (size_t)(row0 + tid) * 64; float s1 = 0.f, s2 = 0.f;
#pragma unroll
            for (int j = 0; j < 16; ++j) { const f32x4 t = *(const f32x4*)(q + 4 * j); s1 += t[0] + t[2]; s2 += t[1] + t[3]; }
            const float mean = s1 * (1.0f / 2048.0f); stt[tid] = mean; stt[128 + tid] = rsqrtf(fmaxf(s2 * (1.0f / 2048.0f) - mean * mean, 0.f) + 1e-6f); }
        __syncthreads();
#pragma unroll 2
        for (int j = 0; j < 8; ++j) { const int e = tid + 512 * j, s = e & 127, d8 = (e >> 7) * 8; const u32x4 xw = *(const u32x4*)(UV + (size_t)(row0 + s) * 4096 + 2048 + g * 256 + d8);
            const f32x4 x0 = unpack4((u32x2){xw.x, xw.y}), x1 = unpack4((u32x2){xw.z, xw.w}); const float mean = stt[s], rstd = stt[128 + s];
            const f32x4 n0 = (x0 - mean) * rstd * *(const f32x4*)(vw + g * 256 + d8) + *(const f32x4*)(vbias + g * 256 + d8), n1 = (x1 - mean) * rstd * *(const f32x4*)(vw + g * 256 + d8 + 4) + *(const f32x4*)(vbias + g * 256 + d8 + 4);
#pragma unroll
            for (int jj = 0; jj < 4; ++jj) { vT[(d8 + jj) * 136 + s] = f2bf(n0[jj]); vT[(d8 + 4 + jj) * 136 + s] = f2bf(n1[jj]); } }
        __syncthreads();
        { const int i = wv; f32x4 acc[16];
#pragma unroll
          for (int j = 0; j < 16; ++j) acc[j] = (f32x4){0.f, 0.f, 0.f, 0.f};
          const int t = 16 * i + fr; const float* wsr = p.b_w_s + ((size_t)(li * 8 + g) * 128 + t) * 128;
          const int rp0 = 8 * (fr >> 2) + (fr & 3), rp1 = rp0 + 4;
          u32x4 uu[8];
#pragma unroll
          for (int pp = 0; pp < 8; ++pp) uu[pp] = *(const u32x4*)(UV + ((size_t)row0 + t) * 4096 + g * 256 + 32 * pp + 8 * fq);
          for (int ks = 0; ks <= (i >> 1); ++ks) { const int s0 = 32 * ks + 8 * fq; f32x4 w0 = *(const f32x4*)(wsr + s0), w1 = *(const f32x4*)(wsr + s0 + 4);
#pragma unroll
              for (int jj = 0; jj < 4; ++jj) { if (s0 + jj > t) w0[jj] = 0.f; if (s0 + 4 + jj > t) w1[jj] = 0.f; }
              const bf16x8 wf = pack8(w0, w1);
#pragma unroll
              for (int j = 0; j < 16; ++j) { const int vrow = 32 * (j >> 1) + ((j & 1) ? rp1 : rp0); const bf16x8 vfr = *(const bf16x8*)(vT + vrow * 136 + 32 * ks + 8 * fq); acc[j] = __builtin_amdgcn_mfma_f32_16x16x32_bf16(vfr, wf, acc[j], 0, 0, 0); } }
          const float bias = p.b_b_s[(li * 8 + g) * 128 + t]; const size_t row = (size_t)row0 + t;
#pragma unroll
          for (int pp = 0; pp < 8; ++pp) { const u32x2 pa = pack4(unpack4((u32x2){uu[pp].x, uu[pp].y}) * (acc[2 * pp] + bias)), pb = pack4(unpack4((u32x2){uu[pp].z, uu[pp].w}) * (acc[2 * pp + 1] + bias));
              *(u32x4*)(OB + row * 2048 + g * 256 + 32 * pp + 8 * fq) = (u32x4){pa.x, pa.y, pb.x, pb.y}; } }
        __syncthreads();
    }
}

__host__ __device__ __forceinline__ void decode_phase(int ph, int& kind, int& layer, int& f) {
    layer = 0; f = 0;
    if (ph < 4) { kind = ph; return; }
    if (ph == NPHASE - 1) { kind = 11; return; }
    int q = ph - 4, s; if (q < 8) { layer = 0; s = q; } else if (q < 15) { layer = 1; s = q - 8; } else if (q < 23) { layer = 2; s = q - 15; } else { layer = 3; s = q - 23; }
    if ((layer & 1) == 0) { f = s >= 6; kind = (s == 0 || s == 6) ? 4 : (s == 1 || s == 7) ? 5 : (s == 2) ? 6 : (s == 3) ? 7 : (s == 4) ? 8 : 10; }
    else { f = s >= 5; kind = (s == 0 || s == 5) ? 4 : (s == 1 || s == 6) ? 5 : (s == 2) ? 6 : (s == 3) ? 9 : 10; }
}
template <int KIND> __device__ __forceinline__ void run_kind(const Params& p, int layer, int f, unsigned char* lds) {
    PG8_LAS unsigned char* ldsl = (PG8_LAS unsigned char*)lds;
    unsigned char* ws = p.ws; const int G = gridDim.x, cid = blockIdx.x;
    bf16_t* W1 = (bf16_t*)(ws + OFF_W1); float* mod = (float*)(ws + OFF_MOD); float* cb = (float*)(ws + OFF_CB); bf16_t* An = (bf16_t*)(ws + OFF_AN);
    float* ssq = (float*)(ws + OFF_SSQ); bf16_t* ACTB = (bf16_t*)(ws + OFF_R1); bf16_t* PROJ = (bf16_t*)(ws + OFF_PROJ); bf16_t* OAB = (bf16_t*)(ws + OFF_OAB);
    const int li = layer >> 1;
    if constexpr (KIND == 0) { phase_convert(p, lds); }
    else if constexpr (KIND == 1) { pg8::Gemm g{(const bf16_t*)(ws + OFF_SC), (const bf16_t*)(ws + OFF_R1), 256, MODLD, 1024}; pg8::StaticOrder S; S.init(256, MODLD, G, cid); EpiMod E{mod, p.b_ada};
        pg8::gemm_phase<EpiMod, pg8::StaticOrder>(ldsl, g, S, E, nullptr); }
    else if constexpr (KIND == 2) { phase_prep0(p); }
    else if constexpr (KIND == 3) { pg8::Gemm g{(const bf16_t*)(ws + OFF_SH), W1, 3072, CBLD, 1024}; CbOrder S{G, cid}; EpiCb E{cb};
        pg8::gemm_phase<EpiCb, CbOrder>(ldsl, g, S, E, nullptr); }
    else if constexpr (KIND == 4) { const int t0 = layer * 60 + (f ? 38 : 0); pg8::Gemm g{An, W1 + (size_t)t0 * 256 * 1024, 16384, 5632, 1024}; pg8::StaticOrder S; S.init(16384, 5632, G, cid);
        SkArgs a{}; a.A = An + (size_t)16384 * 1024; a.Bt = g.Bt; a.K = 1024; a.N = 5632; a.cb = cb + (size_t)t0 * 256; a.O = ACTB; skinny_phase<0, 8>(p, a, 0, lds);
        EpiSwiglu E{ACTB, ssq, cb + (size_t)t0 * 256}; pg8::gemm_phase<EpiSwiglu, pg8::StaticOrder>(ldsl, g, S, E, nullptr); }
    else if constexpr (KIND == 13) { const int t0 = layer * 60 + (f ? 38 : 0); pg8::Gemm g{An, W1 + (size_t)t0 * 256 * 1024, 16384, 5632, 1024}; pg8::StaticOrder S; S.init(16384, 5632, G, cid);
        EpiDummy E{PROJ}; pg8::gemm_phase<EpiDummy, pg8::StaticOrder>(ldsl, g, S, E, nullptr); }
    else if constexpr (KIND == 5 || KIND == 10) {
        pg8::Gemm g; EpiResid E; E.An = An; E.ssq = ssq; E.mod = mod;
        if (KIND == 5) { g = pg8::Gemm{ACTB, (const bf16_t*)(ws + OFF_WDN) + (size_t)(layer * 2 + f) * 1024 * 2816, 16384, 1024, 2816}; E.goff = layer * 9216 + (f ? 2 : 0) * 3072 + 2048; E.coef = 0.5f; E.pw = p.norm_w + (layer * 3 + (f ? 2 : 0)) * 1024; E.poff = layer * 9216 + (f ? 2 : 0) * 3072 + 1024;
            if (!f) { E.nw = p.norm_w + (layer * 3 + 1) * 1024; E.soff = layer * 9216 + 3072 + 1024; }
            else if (layer < 3) { E.nw = p.norm_w + ((layer + 1) * 3) * 1024; E.soff = (layer + 1) * 9216 + 1024; }
            else { E.nw = nullptr; E.soff = 0; } }
        else { g = pg8::Gemm{OAB, (layer & 1) ? (const bf16_t*)(ws + OFF_WOB) + (size_t)li * 1024 * 2048 : (const bf16_t*)(ws + OFF_WOA) + (size_t)li * 1024 * 1024, 16384, 1024, (layer & 1) ? 2048 : 1024};
            E.goff = layer * 9216 + 3072 + 2048; E.coef = 1.0f; E.nw = p.norm_w + (layer * 3 + 2) * 1024; E.soff = layer * 9216 + 2 * 3072 + 1024; E.pw = p.norm_w + (layer * 3 + 1) * 1024; E.poff = layer * 9216 + 3072 + 1024; }
        g.M = 16384; pg8::StaticOrder S; S.init(16384, 1024, G, cid); pg8::gemm_phase<EpiResid, pg8::StaticOrder>(ldsl, g, S, E, nullptr);
        SkArgs a{}; a.A = g.A + (size_t)16384 * g.K; a.Bt = g.Bt; a.K = g.K; a.N = 1024; a.An = An; a.mod = mod; a.nw = E.nw; a.pw = E.pw; a.goff = E.goff; a.soff = E.soff; a.poff = E.poff; a.coef = E.coef; skinny_phase<1, 2>(p, a, 1, lds); }
    else if constexpr (KIND == 6) { const int t0 = layer * 60 + 22; pg8::Gemm g{An, W1 + (size_t)t0 * 256 * 1024, 16384, 4096, 1024}; pg8::StaticOrder S; S.init(16384, 4096, G, cid);
        SkArgs a{}; a.A = An + (size_t)16384 * 1024; a.Bt = g.Bt; a.K = 1024; a.N = 4096; a.cb = cb + (size_t)t0 * 256; a.O = PROJ; skinny_phase<2, 8>(p, a, 2, lds);
        EpiProj<0> E{PROJ, ssq, cb + (size_t)t0 * 256, nullptr}; pg8::gemm_phase<EpiProj<0>, pg8::StaticOrder>(ldsl, g, S, E, nullptr); }
    else if constexpr (KIND == 12) { const int t0 = layer * 60 + 22; pg8::Gemm g{An, W1 + (size_t)t0 * 256 * 1024, 16384, 4096, 1024}; pg8::StaticOrder S; S.init(16384, 4096, G, cid);
        SkArgs a{}; a.A = An + (size_t)16384 * 1024; a.Bt = g.Bt; a.K = 1024; a.N = 4096; a.cb = cb + (size_t)t0 * 256; a.O = PROJ; skinny_phase<3, 8>(p, a, 2, lds);
        EpiProj<1> E{PROJ, ssq, cb + (size_t)t0 * 256, (float*)(ws + OFF_LNP)}; pg8::gemm_phase<EpiProj<1>, pg8::StaticOrder>(ldsl, g, S, E, nullptr); }
    else if constexpr (KIND == 7) { prep_phase(p, li, lds); }
    else if constexpr (KIND == 8) { if (G <= 64) { for (int bh = cid; bh < 64; bh += G) scan_block(p, li, bh, lds); for (int it = cid; it < 1024; it += G) sampleA_item(p, li, it >> 3, it & 7, lds); }
        else if (cid < 64) scan_block(p, li, cid, lds);
        else for (int it = cid - 64; it < 1024; it += G - 64) sampleA_item(p, li, it >> 3, it & 7, lds); }
    else if constexpr (KIND == 9) { mixB_phase(p, li, lds); }
    else if constexpr (KIND == 11) { phase_final(p); }
}
__device__ __forceinline__ void run_phase(const Params& p, int ph, unsigned char* lds, bool dummy = false) {
    int kind, layer, f; decode_phase(ph, kind, layer, f);
    if (kind == 6 && (layer & 1)) kind = 12;
#ifdef MK_PROBE_DUMMY
    if (kind == 4 && dummy) kind = 13;
#endif
    switch (kind) {
        case 0: run_kind<0>(p, layer, f, lds); break; case 1: run_kind<1>(p, layer, f, lds); break; case 2: run_kind<2>(p, layer, f, lds); break; case 3: run_kind<3>(p, layer, f, lds); break;
        case 4: run_kind<4>(p, layer, f, lds); break; case 5: run_kind<5>(p, layer, f, lds); break; case 6: run_kind<6>(p, layer, f, lds); break; case 7: run_kind<7>(p, layer, f, lds); break;
        case 8: run_kind<8>(p, layer, f, lds); break; case 9: run_kind<9>(p, layer, f, lds); break; case 10: run_kind<10>(p, layer, f, lds); break; case 11: run_kind<11>(p, layer, f, lds); break;
        case 12: run_kind<12>(p, layer, f, lds); break;
#ifdef MK_PROBE_DUMMY
        case 13: run_kind<13>(p, layer, f, lds); break;
#endif
        default: break; }
}
#if MK_MULTI
template <int KIND> __global__ void __launch_bounds__(512, 2) mk_kind(Params p, int layer, int f) {
    extern __shared__ __attribute__((aligned(16))) unsigned char lds[];
    run_kind<KIND>(p, layer, f, lds);
}
#else
__global__ void __launch_bounds__(512, 2) mk_fwd(Params p) {
    extern __shared__ __attribute__((aligned(16))) unsigned char lds[];
    cg::grid_group grid = cg::this_grid();
    volatile LAS unsigned* xst = (volatile LAS unsigned*)(lds + LDS_BYTES - 16);
    if (threadIdx.x == 0) { xst[0] = 0u; xst[1] = 0u; }
    __syncthreads();
    const XcdBarrier xb = xcd_barrier_post((unsigned*)(p.ws + OFF_BAR), xst);
#ifdef MK_REPEAT_KIND
    for (int it_ = 2 * p.ph_lo; it_ < 2 * p.ph_hi; ++it_) { const int ph = it_ >> 1;
        { int kind_, layer_, f_; decode_phase(ph, kind_, layer_, f_); if ((it_ & 1) == 0 && kind_ != MK_REPEAT_KIND) continue; }
#else
    for (int ph = p.ph_lo; ph < p.ph_hi; ++ph) {
#endif
        Params q = p;
        long long z_ = 0; asm volatile("" : "+s"(z_));
#define LND(m) q.m = (decltype(q.m))((const unsigned char*)p.m + z_);
        LND(x_prompt) LND(x_sample) LND(st_conv) LND(st_S) LND(c_prompt) LND(c_sample) LND(w_ada) LND(b_ada) LND(norm_w) LND(w_gu) LND(w_down) LND(a_w_in) LND(a_w_conv) LND(a_log) LND(a_dt_bias)
        LND(a_w_onorm) LND(a_w_out) LND(b_w_in) LND(b_vnorm_w) LND(b_vnorm_b) LND(b_w_s) LND(b_b_s) LND(b_w_out) LND(final_w)
        q.out = (float*)((unsigned char*)p.out + z_); q.ws = p.ws + z_;
#undef LND
#if defined(MK_REPEAT_KIND) && defined(MK_PROBE_DUMMY)
        run_phase(q, ph, lds, (it_ & 1) == 0);
#else
        run_phase(q, ph, lds);
#endif
        if (ph + 1 < p.ph_hi) {
            if (MK_COOP && p.ph_hi < 0) { __syncthreads(); grid.sync(); }
            xcd_barrier(xb);
        }
    }
}
#endif

#if MK_MULTI
template <int KIND> static void launch_kind(const Params& p, int layer, int f, int grid, hipStream_t stream) {
    static bool attr = false;
    if (!attr) { (void)hipFuncSetAttribute((const void*)mk_kind<KIND>, hipFuncAttributeMaxDynamicSharedMemorySize, LDS_BYTES); attr = true; }
    hipLaunchKernelGGL(mk_kind<KIND>, dim3(grid), dim3(512), LDS_BYTES, stream, p, layer, f);
}
#endif
extern "C" void kernel_launch(void* const* d_in, const int* in_sizes, int n_in, void* d_out, int out_size, void* d_ws, size_t ws_size, hipStream_t stream) {
    static int grid = 0;
    if (grid == 0) {
        if (n_in != 24 || ws_size < WS_NEED) { fprintf(stderr, "kernel_launch: n_in %d ws %zu need %zu\n", n_in, ws_size, (size_t)WS_NEED); grid = -1; return; }
        int dev = 0, cus = 0;
        (void)hipGetDevice(&dev); (void)hipDeviceGetAttribute(&cus, hipDeviceAttributeMultiprocessorCount, dev);
#if !MK_MULTI
        int per_cu = 0;
        if (hipFuncSetAttribute((const void*)mk_fwd, hipFuncAttributeMaxDynamicSharedMemorySize, LDS_BYTES) != hipSuccess) { fprintf(stderr, "kernel_launch: hipFuncSetAttribute failed\n"); grid = -1; return; }
        (void)hipOccupancyMaxActiveBlocksPerMultiprocessor(&per_cu, (const void*)mk_fwd, 512, LDS_BYTES);
        (void)hipGetLastError();
        if (per_cu < 1) fprintf(stderr, "kernel_launch: occupancy query says %d\n", per_cu);
#endif
        grid = cus;
    }
    if (grid < 0) return;
    Params p{};
    const float** pp = (const float**)&p;
    for (int i = 0; i < 24; ++i) pp[i] = (const float*)d_in[i];
    p.out = (float*)d_out; p.ws = (unsigned char*)d_ws;
#if MK_MULTI
    for (int ph = 0; ph < NPHASE; ++ph) { int kind, layer, f; decode_phase(ph, kind, layer, f); if (kind == 6 && (layer & 1)) kind = 12;
        switch (kind) {
            case 0: launch_kind<0>(p, layer, f, grid, stream); break; case 1: launch_kind<1>(p, layer, f, grid, stream); break; case 2: launch_kind<2>(p, layer, f, grid, stream); break;
            case 3: launch_kind<3>(p, layer, f, grid, stream); break; case 4: launch_kind<4>(p, layer, f, grid, stream); break; case 5: launch_kind<5>(p, layer, f, grid, stream); break;
            case 6: launch_kind<6>(p, layer, f, grid, stream); break; case 7: launch_kind<7>(p, layer, f, grid, stream); break; case 8: launch_kind<8>(p, layer, f, grid, stream); break;
            case 9: launch_kind<9>(p, layer, f, grid, stream); break; case 10: launch_kind<10>(p, layer, f, grid, stream); break; case 11: launch_kind<11>(p, layer, f, grid, stream); break;
            case 12: launch_kind<12>(p, layer, f, grid, stream); break; default: break; } }
#else
    p.ph_lo = 0; p.ph_hi = NPHASE;
    (void)hipMemsetAsync((unsigned char*)d_ws + OFF_BAR, 0, XCD_BAR_WORDS * 4, stream);
    void* args[] = {&p};
#if MK_COOP
    hipError_t e = hipLaunchCooperativeKernel((const void*)mk_fwd, dim3(grid), dim3(512), args, LDS_BYTES, stream);
#else
    hipError_t e = hipLaunchKernel((const void*)mk_fwd, dim3(grid), dim3(512), args, LDS_BYTES, stream);
#endif
    if (e != hipSuccess) fprintf(stderr, "cooperative launch failed: %s (grid %d)\n", hipGetErrorString(e), grid);
#endif
}
```
